# Optimizing an MI355X kernel written in HIP

```python
import jax, jax.numpy as jnp
from jax import lax
import numpy as np

D_MODEL = 1024
BATCH = 1
SEQ = 16384
DEPTH = 1
DEC_BATCH = 32
DEC_SEQ = 2048
PAST_LEN = 128

PLE_DIM = 256
D_FF = 2816
ROPE_THETA = 500000.0
NORM_EPS = 1e-6
NEG_INF = -1e30
MLA_HEADS = 8
Q_LORA = 512
KV_LORA = 256
QK_NOPE = 128
QK_ROPE = 64
QK_HEAD = QK_NOPE + QK_ROPE
V_HEAD = 128
MLA_QBLK = 128
DIL_PATTERN = ((128, 1), (512, 4), (2048, 16))
N_GROUPS = 3
DIL_HEADS = 8
DIL_HEAD = 64
DIL_ROT = DIL_HEAD // 4
DIL_BLK = 64
DIL_QKV = 3 * N_GROUPS * DIL_HEADS * DIL_HEAD
N_BRANCH = 2
IN_SPLITS = (Q_LORA, Q_LORA + KV_LORA, Q_LORA + KV_LORA + QK_ROPE, Q_LORA + KV_LORA + QK_ROPE + DIL_QKV)
D_IN = Q_LORA + KV_LORA + QK_ROPE + DIL_QKV + N_BRANCH * D_MODEL

kernel_name = 'hybrid_mla_dilated_macaron_encoder'


def rmsnorm(x, g):
    xf = x.astype(jnp.float32)
    y = xf * lax.rsqrt(jnp.mean(xf * xf, axis=-1, keepdims=True) + NORM_EPS)
    return (y * g.astype(jnp.float32)).astype(x.dtype)


def swiglu(x, w_gate, w_up, w_down):
    return (jax.nn.silu(x @ w_gate) * (x @ w_up)) @ w_down


def rotary(x):
    s, r = x.shape[1], x.shape[-1]
    inv = ROPE_THETA ** (-jnp.arange(0, r, 2, dtype=jnp.float32) / r)
    ang = jnp.arange(s, dtype=jnp.float32)[:, None] * inv[None, :]
    cos = jnp.cos(ang)[None, :, None, :]
    sin = jnp.sin(ang)[None, :, None, :]
    x1, x2 = jnp.split(x.astype(jnp.float32), 2, axis=-1)
    return jnp.concatenate([x1 * cos - x2 * sin, x2 * cos + x1 * sin], axis=-1).astype(x.dtype)


def mla_attention(q, k, v):
    b, s, h, dq = q.shape
    nq = s // MLA_QBLK
    qb = q.reshape(b, nq, MLA_QBLK, h, dq).transpose(1, 0, 2, 3, 4)
    scale = dq ** -0.5

    def one_block(qblk):
        sc = jnp.einsum('bqhd,bkhd->bhqk', qblk, k).astype(jnp.float32) * scale
        pr = jax.nn.softmax(sc, axis=-1)
        return jnp.einsum('bhqk,bkhd->bqhd', pr.astype(v.dtype), v)

    o = lax.map(one_block, qb)
    return o.transpose(1, 0, 2, 3, 4).reshape(b, s, h, v.shape[-1])


def dilated_group(q, k, v, dilation, n_side):
    b, s, h, dh = q.shape
    L = s // dilation
    nb = -(-L // DIL_BLK)
    lp = nb * DIL_BLK

    def sub(t):
        return t.reshape(b, L, dilation, h, dh).transpose(0, 2, 1, 3, 4)

    qs = jnp.pad(sub(q), ((0, 0), (0, 0), (0, lp - L), (0, 0), (0, 0))).reshape(b, dilation, nb, DIL_BLK, h, dh)

    def band(t):
        tp = jnp.pad(sub(t), ((0, 0), (0, 0), (DIL_BLK, lp - L + DIL_BLK), (0, 0), (0, 0)))
        tp = tp.reshape(b, dilation, nb + 2, DIL_BLK, h, dh)
        return jnp.concatenate([tp[:, :, :-2], tp[:, :, 1:-1], tp[:, :, 2:]], axis=3)

    kw, vw = band(k), band(v)
    qi = jnp.arange(DIL_BLK)[:, None]
    kt = jnp.arange(3 * DIL_BLK)[None, :]
    rel = kt - DIL_BLK - qi
    jk = jnp.arange(nb)[:, None, None] * DIL_BLK + (kt - DIL_BLK)[None]
    valid = (jnp.abs(rel) <= n_side)[None] & (jk >= 0) & (jk < L)

    sc = jnp.einsum('brnqhd,brnkhd->brnhqk', qs, kw).astype(jnp.float32) * (dh ** -0.5)
    sc = jnp.where(valid[None, None, :, None], sc, NEG_INF)
    lse = jax.nn.logsumexp(sc, axis=-1)
    pr = jnp.exp(sc - lse[..., None])
    o = jnp.einsum('brnhqk,brnkhd->brnqhd', pr.astype(v.dtype), vw)
    o = o.reshape(b, dilation, lp, h, dh)[:, :, :L].transpose(0, 2, 1, 3, 4).reshape(b, s, h, dh)
    lse = lse.transpose(0, 1, 2, 4, 3).reshape(b, dilation, lp, h)[:, :, :L].transpose(0, 2, 1, 3).reshape(b, s, h)
    return o, lse


def partial_rotary(x):
    return jnp.concatenate([rotary(x[..., :DIL_ROT]), x[..., DIL_ROT:]], axis=-1)


def encoder_layer(x, p, ffn1_norm, ffn1_w_gate, ffn1_w_up, ffn1_w_down, mix_norm, w_in,
                  q_a_norm, w_uq, kv_a_norm, w_ukv, mla_q_norm, mla_k_norm, dil_q_norm, dil_k_norm,
                  w_o_mla, w_o_dil, w_out, ffn2_norm, ffn2_w_gate, ffn2_w_up, ffn2_w_down,
                  ple_norm, w_ple, w_ple_gate):
    b, s, _ = x.shape
    x = x + 0.5 * swiglu(rmsnorm(x, ffn1_norm), ffn1_w_gate, ffn1_w_up, ffn1_w_down)

    u = rmsnorm(x, mix_norm)
    c_q, c_kv, k_pe, dil, gate_logits = jnp.split(u @ w_in, IN_SPLITS, axis=-1)

    q = (rmsnorm(c_q, q_a_norm) @ w_uq).reshape(b, s, MLA_HEADS, QK_HEAD)
    kv = (rmsnorm(c_kv, kv_a_norm) @ w_ukv).reshape(b, s, MLA_HEADS, QK_NOPE + V_HEAD)
    k_nope, v_mla = kv[..., :QK_NOPE], kv[..., QK_NOPE:]
    k = jnp.concatenate([k_nope, jnp.broadcast_to(k_pe[:, :, None, :], (b, s, MLA_HEADS, QK_ROPE))], axis=-1)
    q = rmsnorm(q, mla_q_norm)
    k = rmsnorm(k, mla_k_norm)
    q = jnp.concatenate([q[..., :QK_NOPE], rotary(q[..., QK_NOPE:])], axis=-1)
    k = jnp.concatenate([k[..., :QK_NOPE], rotary(k[..., QK_NOPE:])], axis=-1)
    o_mla = mla_attention(q, k, v_mla).reshape(b, s, MLA_HEADS * V_HEAD)

    dil = dil.reshape(b, s, N_GROUPS, 3, DIL_HEADS, DIL_HEAD)
    outs, lses = [], []
    for g, (window, dilation) in enumerate(DIL_PATTERN):
        qg = partial_rotary(rmsnorm(dil[:, :, g, 0], dil_q_norm[g]))
        kg = partial_rotary(rmsnorm(dil[:, :, g, 1], dil_k_norm[g]))
        og, lg = dilated_group(qg, kg, dil[:, :, g, 2], dilation, window // (2 * dilation))
        outs.append(og)
        lses.append(lg)
    w_grp = jax.nn.softmax(jnp.stack(lses, axis=0), axis=0)
    o_dil = jnp.einsum('gbsh,gbshd->bshd', w_grp, jnp.stack(outs, axis=0).astype(jnp.float32))
    o_dil = o_dil.astype(x.dtype).reshape(b, s, DIL_HEADS * DIL_HEAD)

    gates = jax.nn.sigmoid(gate_logits)
    g_a, g_b = gates[..., :D_MODEL], gates[..., D_MODEL:]
    x = x + (g_a * (o_mla @ w_o_mla) + g_b * (o_dil @ w_o_dil)) @ w_out

    x = x + 0.5 * swiglu(rmsnorm(x, ffn2_norm), ffn2_w_gate, ffn2_w_up, ffn2_w_down)

    x = x + jax.nn.sigmoid(rmsnorm(x, ple_norm) @ w_ple_gate) * (p @ w_ple)
    return x


def setup_inputs(seed: int = 0) -> dict:
    key = jax.random.key(seed)
    ks = jax.random.split(key, 32)
    f32 = jnp.float32

    def nrm(k, shape, scale):
        return jax.random.normal(k, shape, f32) * scale

    def gain(k, shape):
        return 1.0 + 0.02 * jax.random.normal(k, shape, f32)

    L = DEPTH
    return {
        'x_prompt': nrm(ks[0], (BATCH, SEQ, D_MODEL), 1.0),
        'x_sample': nrm(ks[1], (DEC_BATCH, DEC_SEQ, D_MODEL), 1.0),
        'p_prompt': nrm(ks[2], (DEPTH, BATCH, SEQ, PLE_DIM), 1.0),
        'p_sample': nrm(ks[3], (DEPTH, DEC_BATCH, DEC_SEQ, PLE_DIM), 1.0),
        'ffn1_norm': gain(ks[4], (L, D_MODEL)),
        'ffn1_w_gate': nrm(ks[5], (L, D_MODEL, D_FF), D_MODEL ** -0.5),
        'ffn1_w_up': nrm(ks[6], (L, D_MODEL, D_FF), D_MODEL ** -0.5),
        'ffn1_w_down': nrm(ks[7], (L, D_FF, D_MODEL), D_FF ** -0.5),
        'mix_norm': gain(ks[8], (L, D_MODEL)),
        'w_in': nrm(ks[9], (L, D_MODEL, D_IN), D_MODEL ** -0.5),
        'q_a_norm': gain(ks[10], (L, Q_LORA)),
        'w_uq': nrm(ks[11], (L, Q_LORA, MLA_HEADS * QK_HEAD), Q_LORA ** -0.5),
        'kv_a_norm': gain(ks[12], (L, KV_LORA)),
        'w_ukv': nrm(ks[13], (L, KV_LORA, MLA_HEADS * (QK_NOPE + V_HEAD)), KV_LORA ** -0.5),
        'mla_q_norm': gain(ks[14], (L, QK_HEAD)),
        'mla_k_norm': gain(ks[15], (L, QK_HEAD)),
        'dil_q_norm': gain(ks[16], (L, N_GROUPS, DIL_HEAD)),
        'dil_k_norm': gain(ks[17], (L, N_GROUPS, DIL_HEAD)),
        'w_o_mla': nrm(ks[18], (L, MLA_HEADS * V_HEAD, D_MODEL), (MLA_HEADS * V_HEAD) ** -0.5),
        'w_o_dil': nrm(ks[19], (L, DIL_HEADS * DIL_HEAD, D_MODEL), (DIL_HEADS * DIL_HEAD) ** -0.5),
        'w_out': nrm(ks[20], (L, D_MODEL, D_MODEL), D_MODEL ** -0.5),
        'ffn2_norm': gain(ks[21], (L, D_MODEL)),
        'ffn2_w_gate': nrm(ks[22], (L, D_MODEL, D_FF), D_MODEL ** -0.5),
        'ffn2_w_up': nrm(ks[23], (L, D_MODEL, D_FF), D_MODEL ** -0.5),
        'ffn2_w_down': nrm(ks[24], (L, D_FF, D_MODEL), D_FF ** -0.5),
        'ple_norm': gain(ks[25], (L, D_MODEL)),
        'w_ple': nrm(ks[26], (L, PLE_DIM, D_MODEL), PLE_DIM ** -0.5),
        'w_ple_gate': nrm(ks[27], (L, D_MODEL, D_MODEL), D_MODEL ** -0.5),
    }


def reference(x_prompt, x_sample, p_prompt, p_sample, ffn1_norm, ffn1_w_gate, ffn1_w_up, ffn1_w_down,
              mix_norm, w_in, q_a_norm, w_uq, kv_a_norm, w_ukv, mla_q_norm, mla_k_norm,
              dil_q_norm, dil_k_norm, w_o_mla, w_o_dil, w_out, ffn2_norm, ffn2_w_gate, ffn2_w_up,
              ffn2_w_down, ple_norm, w_ple, w_ple_gate):
    weights = (ffn1_norm, ffn1_w_gate, ffn1_w_up, ffn1_w_down, mix_norm, w_in, q_a_norm, w_uq,
               kv_a_norm, w_ukv, mla_q_norm, mla_k_norm, dil_q_norm, dil_k_norm, w_o_mla, w_o_dil,
               w_out, ffn2_norm, ffn2_w_gate, ffn2_w_up, ffn2_w_down, ple_norm, w_ple, w_ple_gate)

    def run(x, p):
        for i in range(DEPTH):
            x = encoder_layer(x, p[i], *[w[i] for w in weights])
        return x

    y_prompt = run(x_prompt, p_prompt)
    y_sample = run(x_sample, p_sample)
    return (y_prompt, y_sample)
```

```cpp
#include <hip/hip_runtime.h>
#include <hip/hip_cooperative_groups.h>
#include <cstdio>
#include <cstdint>
namespace cg = cooperative_groups;
namespace pg8 {
#define PG8_LAS __attribute__((address_space(3)))
typedef unsigned short bf16_t;
typedef short bf16x8 __attribute__((ext_vector_type(8)));
typedef float f32x4 __attribute__((ext_vector_type(4)));
typedef unsigned u32x4 __attribute__((ext_vector_type(4)));
constexpr int BM = 256, BK = 64, HALF = 128, HTB = HALF * BK * 2  , STAGE_BYTES = 8 * HTB, NXCD = 8, WGM = 8;

__host__ __device__ __forceinline__ int lds_byte(int r, int c) { const int st = (r >> 4) * 2 + (c >> 5), rr = r & 15, cc = c & 31, ob = rr * 64 + cc * 2; return st * 1024 + (ob ^ (((ob >> 9) & 1) << 5)); }
__host__ __device__ __forceinline__ void stage_rc(int b, int& R, int& C) { const int st = b / 1024, sb = b % 1024, swz = sb ^ (((sb >> 9) & 1) << 5); R = (st >> 1) * 16 + swz / 64; C = (st & 1) * 32 + (swz % 64) / 2; }
__host__ __device__ __forceinline__ int perm32(int rho) { const int n = rho >> 4, i = rho & 15; return 8 * (i >> 2) + 4 * n + (i & 3); }

struct Unit { int pm, pn; };
struct Gemm { const bf16_t* A; const bf16_t* Bt; int M, N, K; };

struct StaticOrder {
    int nM, nN, nwg, G, c;
    __host__ __device__ void init(int M, int N, int G_, int c_) { nM = M / BM; nN = N / BM; nwg = nM * nN; G = G_; c = c_; }
    __host__ __device__ bool next(int i, Unit& u) const {
        const long L = (long)i * G + c; if (L >= nwg) return false;
        int wgid = (int)L; { const int q = nwg / NXCD, r = nwg % NXCD, xcd = wgid % NXCD, off = wgid / NXCD; wgid = (xcd < r ? xcd * (q + 1) : r * (q + 1) + (xcd - r) * q) + off; }
        const int nig = WGM * nN, gid = wgid / nig, fm = gid * WGM, gsz = (nM - fm) < WGM ? (nM - fm) : WGM;
        u.pm = fm + ((wgid % nig) % gsz); u.pn = (wgid % nig) / gsz; return true;
    }
    __device__ __forceinline__ void a_ready(const Unit&) const {}
    __device__ __forceinline__ void done(const Unit&) const {}
};
typedef float f32x2_cv __attribute__((ext_vector_type(2))); typedef __bf16 bf16x2_cv __attribute__((ext_vector_type(2)));
__device__ __forceinline__ unsigned cvt_pk_bf16(float lo, float hi) { f32x2_cv v = {lo, hi}; bf16x2_cv b = __builtin_convertvector(v, bf16x2_cv); return __builtin_bit_cast(unsigned, b); }
template <class Epi, class Sched, bool ALIGN_EPI = false, bool SP2 = false>
__device__ __forceinline__ void gemm_phase(PG8_LAS unsigned char* lds, const Gemm g, const Sched& S, const Epi& E) {
    int tid_ = threadIdx.x; asm volatile("" : "+v"(tid_));
    const int tid = tid_, wid = __builtin_amdgcn_readfirstlane(tid >> 6), lane = tid & 63, wr = wid >> 2, wc = wid & 3, fr = lane & 15, fq = lane >> 4;
    const int K = g.K, nt = K / BK;
    unsigned voffA[2], voffB[2];
#pragma unroll
    for (int i = 0; i < 2; ++i) { int R, C; stage_rc(tid * 16 + i * 8192, R, C); const int Rb = Epi::PERM ? ((R & ~31) + perm32(R & 31)) : R;
        voffA[i] = (unsigned)(R * K + C) * 2u; voffB[i] = (unsigned)(Rb * K + C) * 2u; }
    const size_t kstep = (size_t)(BK * 2);
    const size_t hstep = (size_t)HALF * K * 2;
    const size_t tstep = 2 * hstep;
    const unsigned ldsw = (unsigned)wid * 1024u; const unsigned ldsb0 = (unsigned)__builtin_amdgcn_readfirstlane((int)((unsigned)(uintptr_t)lds + ldsw));
    const int aoff = lds_byte(wr * 64 + fr, fq * 8), boff = lds_byte(wc * 32 + fr, fq * 8);
#define PG8_SA(b, h) (((b) * 2 + (h)) * HTB)
#define PG8_SB(b, h) ((4 + (b) * 2 + (h)) * HTB)
#define PG8_STAGE(bufoff, gbase, voff) do { _Pragma("unroll") for (int _i = 0; _i < 2; ++_i) \
        asm volatile("s_mov_b32 m0, %0\n\ts_nop 0\n\tglobal_load_lds_dwordx4 %1, %2" :: "s"(ldsb0 + (unsigned)((bufoff) + _i * 8192)), "v"((voff)[_i]), "s"((const char*)(gbase)) : "memory"); } while (0)
#define PG8_LDA(dst, b, h) do { _Pragma("unroll") for (int m = 0; m < 4; ++m) _Pragma("unroll") for (int k = 0; k < 2; ++k) dst[m][k] = *(const PG8_LAS bf16x8*)(lds + PG8_SA(b, h) + aoff + m * 2048 + k * 1024); } while (0)
#define PG8_LDB(dst, b, h) do { _Pragma("unroll") for (int n = 0; n < 2; ++n) _Pragma("unroll") for (int k = 0; k < 2; ++k) dst[n][k] = *(const PG8_LAS bf16x8*)(lds + PG8_SB(b, h) + boff + n * 2048 + k * 1024); } while (0)
#define PG8_MMA(ai, bj, At, Bt) do { __builtin_amdgcn_s_setprio(1); _Pragma("unroll") for (int m = 0; m < 4; ++m) _Pragma("unroll") for (int n = 0; n < 2; ++n) _Pragma("unroll") for (int k = 0; k < 2; ++k) \
        acc[ai][bj][m][n] = __builtin_amdgcn_mfma_f32_16x16x32_bf16(Bt[n][k], At[m][k], acc[ai][bj][m][n], 0, 0, 0); __builtin_amdgcn_s_setprio(0); } while (0)
#define PG8_WAIT_V(n) asm volatile("s_waitcnt vmcnt(" #n ")" ::: "memory")
#define PG8_WAIT_L(n) asm volatile("s_waitcnt lgkmcnt(" #n ")" ::: "memory")
#define PG8_BAR __builtin_amdgcn_s_barrier()
#define PG8_SCHED __builtin_amdgcn_sched_barrier(0)
    Unit cur, nxt; int ui = 0;
    if (!S.next(0, cur)) return;
    f32x4 acc[2][2][4][2];
#pragma unroll
    for (int a = 0; a < 2; ++a)
#pragma unroll
        for (int b = 0; b < 2; ++b)
#pragma unroll
            for (int m = 0; m < 4; ++m)
#pragma unroll
                for (int n = 0; n < 2; ++n) acc[a][b][m][n] = (f32x4){0.f, 0.f, 0.f, 0.f};
    bf16x8 At[4][2], B0[2][2], B1[2][2];
    const char* cA = (const char*)g.A + (size_t)cur.pm * tstep; const char* cB = (const char*)g.Bt + (size_t)cur.pn * tstep;
    S.a_ready(cur);
    if constexpr (SP2) {
        PG8_STAGE(PG8_SB(0, 0), cB, voffB); PG8_STAGE(PG8_SB(0, 1), cB + hstep, voffB); PG8_STAGE(PG8_SA(0, 0), cA, voffA); PG8_STAGE(PG8_SA(0, 1), cA + hstep, voffA);
        if (wr == 1) PG8_BAR;
        PG8_WAIT_V(2); PG8_BAR;
        PG8_STAGE(PG8_SB(1, 0), cB + kstep, voffB); PG8_STAGE(PG8_SA(1, 0), cA + kstep, voffA); PG8_STAGE(PG8_SB(1, 1), cB + hstep + kstep, voffB);
        PG8_WAIT_V(6); PG8_BAR;
    } else {
        PG8_STAGE(PG8_SB(0, 0), cB, voffB); PG8_STAGE(PG8_SA(0, 0), cA, voffA); PG8_STAGE(PG8_SB(0, 1), cB + hstep, voffB); PG8_STAGE(PG8_SA(0, 1), cA + hstep, voffA);
        if (wr == 1) PG8_BAR;
        PG8_WAIT_V(4); PG8_BAR;
        PG8_STAGE(PG8_SB(1, 0), cB + kstep, voffB); PG8_STAGE(PG8_SA(1, 0), cA + kstep, voffA); PG8_STAGE(PG8_SB(1, 1), cB + hstep + kstep, voffB);
        PG8_WAIT_V(6); PG8_BAR;
    }
    for (;;) {
        const bool has_next = S.next(ui + 1, nxt);
        const char* nA = has_next ? (const char*)g.A + (size_t)nxt.pm * tstep : cA; const char* nB = has_next ? (const char*)g.Bt + (size_t)nxt.pn * tstep : cB;
        for (int t = 0; t < nt; t += 2) {
            const bool last = (t == nt - 2);
            const char* a1 = cA + (size_t)(t + 1) * kstep;
            const char* a2 = last ? nA : cA + (size_t)(t + 2) * kstep; const char* b2 = last ? nB : cB + (size_t)(t + 2) * kstep;
            const char* a3 = a2 + kstep; const char* b3 = b2 + kstep;
            if (last && has_next) S.a_ready(nxt);
            if constexpr (SP2) {
            PG8_LDB(B0, 0, 0); PG8_LDB(B1, 0, 1); PG8_SCHED; PG8_LDA(At, 0, 0); PG8_STAGE(PG8_SA(1, 1), a1 + hstep, voffA);
            PG8_WAIT_V(8); PG8_WAIT_L(0); PG8_BAR; PG8_MMA(0, 0, At, B0); PG8_MMA(0, 1, At, B1); PG8_BAR; PG8_SCHED;
            PG8_LDA(At, 0, 1); PG8_STAGE(PG8_SB(0, 0), b2, voffB); PG8_STAGE(PG8_SB(0, 1), b2 + hstep, voffB); PG8_STAGE(PG8_SA(0, 0), a2, voffA);
            PG8_WAIT_V(8); PG8_WAIT_L(0); PG8_BAR; PG8_MMA(1, 0, At, B0); PG8_MMA(1, 1, At, B1); PG8_BAR; PG8_SCHED;
            PG8_LDB(B0, 1, 0); PG8_LDB(B1, 1, 1); PG8_SCHED; PG8_LDA(At, 1, 0); PG8_STAGE(PG8_SA(0, 1), a2 + hstep, voffA);
            PG8_WAIT_V(8); PG8_WAIT_L(0); PG8_BAR; PG8_MMA(0, 0, At, B0); PG8_MMA(0, 1, At, B1); PG8_BAR; PG8_SCHED;
            PG8_LDA(At, 1, 1); PG8_STAGE(PG8_SB(1, 0), b3, voffB); PG8_STAGE(PG8_SB(1, 1), b3 + hstep, voffB); PG8_STAGE(PG8_SA(1, 0), a3, voffA);
            PG8_WAIT_V(8); PG8_WAIT_L(0); PG8_BAR; PG8_MMA(1, 0, At, B0); PG8_MMA(1, 1, At, B1); PG8_BAR; PG8_SCHED;
            } else {
            PG8_LDB(B0, 0, 0); PG8_SCHED; PG8_LDA(At, 0, 0); PG8_STAGE(PG8_SA(1, 1), a1 + hstep, voffA);
            PG8_WAIT_L(8); PG8_BAR; PG8_WAIT_L(0); PG8_MMA(0, 0, At, B0); PG8_BAR; PG8_SCHED;
            PG8_LDB(B1, 0, 1); PG8_STAGE(PG8_SB(0, 0), b2, voffB);
            PG8_BAR; PG8_WAIT_L(0); PG8_MMA(0, 1, At, B1); PG8_BAR;
            PG8_LDA(At, 0, 1); PG8_STAGE(PG8_SA(0, 0), a2, voffA);
            PG8_BAR; PG8_WAIT_L(0); PG8_MMA(1, 0, At, B0); PG8_BAR; PG8_SCHED;
            PG8_STAGE(PG8_SB(0, 1), b2 + hstep, voffB);
            PG8_WAIT_V(6); PG8_BAR; PG8_MMA(1, 1, At, B1); PG8_BAR;
            PG8_LDB(B0, 1, 0); PG8_SCHED; PG8_LDA(At, 1, 0); PG8_STAGE(PG8_SA(0, 1), a2 + hstep, voffA);
            PG8_WAIT_L(8); PG8_BAR; PG8_WAIT_L(0); PG8_MMA(0, 0, At, B0); PG8_BAR; PG8_SCHED;
            PG8_LDB(B1, 1, 1); PG8_STAGE(PG8_SB(1, 0), b3, voffB);
            PG8_BAR; PG8_WAIT_L(0); PG8_MMA(0, 1, At, B1); PG8_BAR;
            PG8_LDA(At, 1, 1); PG8_STAGE(PG8_SA(1, 0), a3, voffA);
            PG8_BAR; PG8_WAIT_L(0); PG8_MMA(1, 0, At, B0); PG8_BAR; PG8_SCHED;
            PG8_STAGE(PG8_SB(1, 1), b3 + hstep, voffB);
            PG8_WAIT_V(6); PG8_BAR; PG8_MMA(1, 1, At, B1); PG8_BAR;
            }
        }
        if constexpr (ALIGN_EPI) { if (wr == 0) PG8_BAR; }
        if constexpr (!Epi::AFTER_DRAIN) { E(acc, cur, wr, wc, fr, fq); S.done(cur); }
        if (!has_next) break;
#pragma unroll
        for (int a = 0; a < 2; ++a)
#pragma unroll
            for (int b = 0; b < 2; ++b)
#pragma unroll
                for (int m = 0; m < 4; ++m)
#pragma unroll
                    for (int n = 0; n < 2; ++n) acc[a][b][m][n] = (f32x4){0.f, 0.f, 0.f, 0.f};
        cur = nxt; cA = nA; cB = nB; ++ui;
        if constexpr (ALIGN_EPI) { if (wr == 1) PG8_BAR; }
    }
    PG8_WAIT_V(0);
    if constexpr (!ALIGN_EPI) { if (wr == 0) PG8_BAR; }
    PG8_BAR;
    if constexpr (Epi::AFTER_DRAIN) { E.fused(acc, cur, wr, wc, fr, fq, lds, wid, lane); S.done(cur); }
#undef PG8_SA
#undef PG8_SB
#undef PG8_STAGE
#undef PG8_LDA
#undef PG8_LDB
#undef PG8_MMA
#undef PG8_WAIT_V
#undef PG8_WAIT_L
#undef PG8_BAR
#undef PG8_SCHED
}
}

#define LAS __attribute__((address_space(3)))
using pg8::bf16_t; using pg8::bf16x8; using pg8::f32x4; using pg8::u32x4; using pg8::Unit; using pg8::cvt_pk_bf16;
typedef float f32x16 __attribute__((ext_vector_type(16)));
typedef short v4i16_t __attribute__((ext_vector_type(4)));
typedef unsigned u32x2 __attribute__((ext_vector_type(2)));

constexpr int T = 81920, TP = 16384, SS = 2048, DM = 1024, FF = 2816, CH = 40960;
constexpr float EPS = 1e-6f, LOG2E = 1.4426950408889634f;
constexpr size_t MiB = 1u << 20;
constexpr size_t W_GU1 = 0, W_D1 = W_GU1 + 5632ull * 1024 * 2, W_GU2 = W_D1 + 1024ull * 2816 * 2, W_D2 = W_GU2 + 5632ull * 1024 * 2,
                 W_DIL = W_D2 + 1024ull * 2816 * 2, W_A = W_DIL + 4608ull * 1024 * 2, W_UQ = W_A + 1024ull * 1024 * 2, W_UKV = W_UQ + 2048ull * 512 * 2,
                 W_G = W_UKV + 2048ull * 256 * 2, W_OA = W_G + 2048ull * 1024 * 2, W_OB = W_OA + 1024ull * 1024 * 2, W_OUT = W_OB + 1024ull * 512 * 2,
                 W_PG = W_OUT + 1024ull * 1024 * 2, W_PE = W_PG + 1024ull * 1024 * 2, W_END = W_PE + 1024ull * 256 * 2;
static_assert(W_END <= 64 * MiB, "weights");
constexpr size_t S_BASE = 64 * MiB;
constexpr size_t S_RS0 = S_BASE, S_SSQ1 = S_RS0 + (size_t)T * 4, S_SSQ2 = S_SSQ1 + (size_t)T * 64, S_SSQ3 = S_SSQ2 + (size_t)T * 64,
                 S_SSQQ = S_SSQ3 + (size_t)T * 64, S_SSQKV = S_SSQQ + (size_t)T * 32, S_SSQPE = S_SSQKV + (size_t)T * 16, S_KPE = S_SSQPE + (size_t)T * 4,
                 S_L0 = S_KPE + (size_t)T * 256, S_L1 = S_L0 + (size_t)T * 32, S_MCOS = S_L1 + (size_t)T * 32, S_MSIN = S_MCOS + 16384ull * 32 * 4,
                 S_DCOS = S_MSIN + 16384ull * 32 * 4, S_DSIN = S_DCOS + 16384ull * 8 * 4, S_END = S_DSIN + 16384ull * 8 * 4;
constexpr size_t S_CTL = (S_END + 4095) / 4096 * 4096, CTL_BYTES = 16384;
static_assert(S_CTL + CTL_BYTES <= 128 * MiB, "small");
constexpr size_t XB_OFF = 128 * MiB;
constexpr size_t R = 288 * MiB;
constexpr size_t R_H = R, R_DIL = R, R_O0 = R + 240 * MiB, R_O1 = R + 320 * MiB, R_OD = R + 656 * MiB;
constexpr size_t R_Q = R, R_K = R + 120 * MiB, R_V = R + 240 * MiB, R_OM = R + 320 * MiB, R_CQ = R + 480 * MiB, R_CKV = R + 520 * MiB;
constexpr size_t R_GATES = R, R_TT = R + 480 * MiB, R_PB = R + 440 * MiB, R_PEO = R + 480 * MiB;
constexpr size_t WS_NEED = 1024 * MiB;

constexpr int LDS_BYTES = 147456, LDS_SCR = 131072;

struct Params { const float* in[28]; float* out; unsigned char* ws; };
typedef const __attribute__((address_space(4))) Params CParams;
__device__ __forceinline__ const void* uniform_ptr(const void* p) { const unsigned long long v = (unsigned long long)p; const unsigned lo = __builtin_amdgcn_readfirstlane((unsigned)v), hi = __builtin_amdgcn_readfirstlane((unsigned)(v >> 32)); return (const void*)(((unsigned long long)hi << 32) | lo); }

__device__ __forceinline__ int tok_pos(int row) { return row < TP ? row : (row & (SS - 1)); }
__device__ __forceinline__ float fsigmoid(float x) { return __builtin_amdgcn_rcpf(1.f + __builtin_amdgcn_exp2f(-x * LOG2E)); }
__device__ __forceinline__ float rs16(const float* ssq, int row) {
    const float a = __hip_atomic_load(ssq + row, __ATOMIC_RELAXED, __HIP_MEMORY_SCOPE_AGENT), b = __hip_atomic_load(ssq + T + row, __ATOMIC_RELAXED, __HIP_MEMORY_SCOPE_AGENT),
                c = __hip_atomic_load(ssq + 2 * T + row, __ATOMIC_RELAXED, __HIP_MEMORY_SCOPE_AGENT), d = __hip_atomic_load(ssq + 3 * T + row, __ATOMIC_RELAXED, __HIP_MEMORY_SCOPE_AGENT);
    return rsqrtf(((a + b) + (c + d)) * (1.f / 1024.f) + EPS);
}
__device__ __forceinline__ u32x4 pack8(f32x4 a, f32x4 b) { u32x4 w; w.x = cvt_pk_bf16(a[0], a[1]); w.y = cvt_pk_bf16(a[2], a[3]); w.z = cvt_pk_bf16(b[0], b[1]); w.w = cvt_pk_bf16(b[2], b[3]); return w; }
__device__ __forceinline__ float bf_lo(unsigned w) { return __builtin_bit_cast(float, w << 16); }
__device__ __forceinline__ float bf_hi(unsigned w) { return __builtin_bit_cast(float, w & 0xffff0000u); }
__device__ __forceinline__ float dot4(f32x4 v) { return (v[0] * v[0] + v[1] * v[1]) + (v[2] * v[2] + v[3] * v[3]); }
__device__ __forceinline__ float quad_sum(float s) { s += __shfl_xor(s, 16); s += __shfl_xor(s, 32); return s; }

#define EPI_ROWS(ai, m) (u.pm * 256 + (ai) * 128 + wr * 64 + (m) * 16 + fr)
typedef f32x4 (&AccRef)[2][2][4][2];

struct EpiSwiglu {
    static constexpr bool PERM = true, AFTER_DRAIN = false;
    const float* rs_direct; const float* ssq16; bf16_t* H;
    __device__ __forceinline__ void operator()(AccRef acc, const Unit& u, int wr, int wc, int fr, int fq) const {
        asm volatile("" : "+v"(fr), "+v"(fq));
#pragma unroll
        for (int ai = 0; ai < 2; ++ai)
#pragma unroll
            for (int m = 0; m < 4; ++m) { asm volatile("" ::: "memory");
                const int row = EPI_ROWS(ai, m); const float rs = rs_direct ? rs_direct[row] : rs16(ssq16, row);
                f32x4 h[2];
                const float nrl = -rs * LOG2E, rs2 = rs * rs;
#pragma unroll
                for (int n = 0; n < 2; ++n) { const f32x4 g = acc[ai][0][m][n], up = acc[ai][1][m][n];
#pragma unroll
                    for (int e = 0; e < 4; ++e) h[n][e] = (g[e] * up[e]) * (rs2 * __builtin_amdgcn_rcpf(1.f + __builtin_amdgcn_exp2f(g[e] * nrl))); }
                *(u32x4*)(H + (size_t)row * FF + u.pn * 128 + wc * 32 + fq * 8) = pack8(h[0], h[1]);
            }
    }
};
template <bool RESBF> struct EpiResid {
    static constexpr bool PERM = true, AFTER_DRAIN = false;
    const float* resA; const float* resB; bf16_t* xb; float* ssq; float scale; LAS float* scr;
    __device__ __forceinline__ void operator()(AccRef acc, const Unit& u, int wr, int wc, int fr, int fq) const {
        asm volatile("" : "+v"(fr), "+v"(fq));
#pragma unroll
        for (int ai = 0; ai < 2; ++ai)
#pragma unroll
            for (int m = 0; m < 4; ++m) { asm volatile("" ::: "memory");
                const int row = EPI_ROWS(ai, m); const float* rp = row < TP ? resA + (size_t)row * DM : resB + (size_t)(row - TP) * DM;
                float part = 0.f;
#pragma unroll
                for (int bj = 0; bj < 2; ++bj) { const int col0 = u.pn * 256 + bj * 128 + wc * 32 + fq * 8; f32x4 v[2];
                    if (RESBF) { const u32x4 p = *(const u32x4*)(xb + (size_t)row * DM + col0);
                        v[0] = (f32x4){bf_lo(p.x), bf_hi(p.x), bf_lo(p.y), bf_hi(p.y)} + acc[ai][bj][m][0] * scale; v[1] = (f32x4){bf_lo(p.z), bf_hi(p.z), bf_lo(p.w), bf_hi(p.w)} + acc[ai][bj][m][1] * scale;
                    } else {
#pragma unroll
                        for (int n = 0; n < 2; ++n) v[n] = *(const f32x4*)(rp + col0 + 4 * n) + acc[ai][bj][m][n] * scale; }
                    part += dot4(v[0]) + dot4(v[1]);
                    *(u32x4*)(xb + (size_t)row * DM + col0) = pack8(v[0], v[1]); }
                part = quad_sum(part);
                if (fq == 0) scr[(ai * 128 + wr * 64 + m * 16 + fr) * 4 + wc] = part;
            }
        asm volatile("s_waitcnt lgkmcnt(0)" ::: "memory"); __builtin_amdgcn_s_barrier(); asm volatile("" ::: "memory");
        if (wc == 0 && fq == 0) {
#pragma unroll
            for (int ai = 0; ai < 2; ++ai)
#pragma unroll
                for (int m = 0; m < 4; ++m) { const f32x4 pp = *(const LAS f32x4*)(scr + (ai * 128 + wr * 64 + m * 16 + fr) * 4);
                    ssq[(size_t)u.pn * T + EPI_ROWS(ai, m)] = (pp[0] + pp[1]) + (pp[2] + pp[3]); }
        }
    }
};
struct EpiDil {
    static constexpr bool PERM = true, AFTER_DRAIN = false;
    const float* ssq16; const float* gq; const float* gk; const float* dcos; const float* dsin; bf16_t* out;
    __device__ __forceinline__ void operator()(AccRef acc, const Unit& u, int wr, int wc, int fr, int fq) const {
        asm volatile("" : "+v"(fr), "+v"(fq));
        const int s = u.pn >> 1, h = (u.pn & 1) * 4 + wc;
        f32x4 g4[2][2];
        if (s < 2) { const float* gp = s == 0 ? gq : gk;
#pragma unroll
            for (int bj = 0; bj < 2; ++bj)
#pragma unroll
                for (int n = 0; n < 2; ++n) { const int d0 = (bj == 0 && fq < 2) ? 4 * fq + 8 * n : bj * 32 + 8 * fq + 4 * n; g4[bj][n] = *(const f32x4*)(gp + d0); } }
#pragma unroll
        for (int ai = 0; ai < 2; ++ai)
#pragma unroll
            for (int m = 0; m < 4; ++m) { asm volatile("" ::: "memory");
                const int row = EPI_ROWS(ai, m); const float rs = rs16(ssq16, row);
                f32x4 v[2][2]; float part = 0.f;
#pragma unroll
                for (int bj = 0; bj < 2; ++bj)
#pragma unroll
                    for (int n = 0; n < 2; ++n) { v[bj][n] = acc[ai][bj][m][n] * rs; part += dot4(v[bj][n]); }
                if (s < 2) {
                    part = quad_sum(part);
                    float rn = rsqrtf(part * (1.f / 64.f) + EPS); if (s == 0) rn *= 0.125f * LOG2E;
#pragma unroll
                    for (int bj = 0; bj < 2; ++bj)
#pragma unroll
                        for (int n = 0; n < 2; ++n) v[bj][n] = v[bj][n] * rn * g4[bj][n];
                    if (fq < 2) { const int pos = tok_pos(row); const f32x4 c = *(const f32x4*)(dcos + pos * 8 + 4 * fq), sn = *(const f32x4*)(dsin + pos * 8 + 4 * fq);
                        const f32x4 x1 = v[0][0], x2 = v[0][1]; v[0][0] = x1 * c - x2 * sn; v[0][1] = x2 * c + x1 * sn; }
                }
                bf16_t* o = out + (size_t)row * 1536 + s * 512 + h * 64 + fq * 8;
                *(u32x4*)(o) = pack8(v[0][0], v[0][1]); *(u32x4*)(o + 32) = pack8(v[1][0], v[1][1]);
            }
    }
};
struct EpiA {
    static constexpr bool PERM = true, AFTER_DRAIN = false;
    const float* ssq16; bf16_t* CQ; bf16_t* CKV; float* SSQQ; float* SSQKV; float* SSQPE; float* KPE; const float* gk; const float* mcos; const float* msin; int row0; LAS float* scr;
    __device__ __forceinline__ void operator()(AccRef acc, const Unit& u, int wr, int wc, int fr, int fq) const {
        asm volatile("" : "+v"(fr), "+v"(fq));
        const int pn = u.pn;
        if (!(pn == 3 && wc != 0)) {
#pragma unroll
        for (int ai = 0; ai < 2; ++ai)
#pragma unroll
            for (int m = 0; m < 4; ++m) { asm volatile("" ::: "memory");
                const int lrow = EPI_ROWS(ai, m), grow = row0 + lrow; const float rs = rs16(ssq16, grow);
                f32x4 v[2][2]; float part = 0.f;
#pragma unroll
                for (int bj = 0; bj < 2; ++bj)
#pragma unroll
                    for (int n = 0; n < 2; ++n) { v[bj][n] = acc[ai][bj][m][n] * rs; part += dot4(v[bj][n]); }
                part = quad_sum(part);
                if (pn < 2) {
                    bf16_t* o = CQ + (size_t)lrow * 512 + pn * 256 + wc * 32 + fq * 8;
                    *(u32x4*)o = pack8(v[0][0], v[0][1]); *(u32x4*)(o + 128) = pack8(v[1][0], v[1][1]);
                } else if (pn == 2) {
                    bf16_t* o = CKV + (size_t)lrow * 256 + wc * 32 + fq * 8;
                    *(u32x4*)o = pack8(v[0][0], v[0][1]); *(u32x4*)(o + 128) = pack8(v[1][0], v[1][1]);
                } else {
                    if (fq == 0) SSQPE[grow] = part;
                    const int pos = tok_pos(grow);
#pragma unroll
                    for (int n = 0; n < 2; ++n) { const int i0 = 8 * fq + 4 * n;
                        const f32x4 a = v[0][n] * *(const f32x4*)(gk + 128 + i0), b = v[1][n] * *(const f32x4*)(gk + 160 + i0);
                        const f32x4 c = *(const f32x4*)(mcos + pos * 32 + i0), sn = *(const f32x4*)(msin + pos * 32 + i0);
                        *(f32x4*)(KPE + (size_t)grow * 64 + i0) = a * c - b * sn; *(f32x4*)(KPE + (size_t)grow * 64 + 32 + i0) = b * c + a * sn; }
                }
                if (fq == 0) scr[(ai * 128 + wr * 64 + m * 16 + fr) * 4 + wc] = part;
            }
        }
        asm volatile("s_waitcnt lgkmcnt(0)" ::: "memory"); __builtin_amdgcn_s_barrier(); asm volatile("" ::: "memory");
        if (pn < 3 && wc == 0 && fq == 0) {
#pragma unroll
            for (int ai = 0; ai < 2; ++ai)
#pragma unroll
                for (int m = 0; m < 4; ++m) { const f32x4 pp = *(const LAS f32x4*)(scr + (ai * 128 + wr * 64 + m * 16 + fr) * 4); const float tot = (pp[0] + pp[1]) + (pp[2] + pp[3]);
                    const int grow = row0 + EPI_ROWS(ai, m);
                    if (pn < 2) SSQQ[(size_t)pn * T + grow] = tot; else SSQKV[grow] = tot; }
        }
    }
};
struct EpiQ {
    static constexpr bool PERM = true, AFTER_DRAIN = false;
    const float* SSQQ; const float* gq; const float* mcos; const float* msin; bf16_t* Q; LAS float* scr; int row0;
    __device__ __forceinline__ void operator()(AccRef acc, const Unit& u, int wr, int wc, int fr, int fq) const {
        asm volatile("" : "+v"(fr), "+v"(fq));
        const int h = u.pn;
#pragma unroll
        for (int ai = 0; ai < 2; ++ai)
#pragma unroll
            for (int m = 0; m < 4; ++m) { asm volatile("" ::: "memory");
                const int grow = row0 + EPI_ROWS(ai, m);
                const float rq = rsqrtf((SSQQ[grow] + SSQQ[T + grow]) * (1.f / 512.f) + EPS);
                float part = 0.f;
#pragma unroll
                for (int bj = 0; bj < 2; ++bj)
#pragma unroll
                    for (int n = 0; n < 2; ++n) { acc[ai][bj][m][n] = acc[ai][bj][m][n] * rq; part += dot4(acc[ai][bj][m][n]); }
                part = quad_sum(part);
                if (fq == 0) scr[(ai * 128 + wr * 64 + m * 16 + fr) * 4 + wc] = part;
            }
        asm volatile("s_waitcnt lgkmcnt(0)" ::: "memory"); __builtin_amdgcn_s_barrier(); asm volatile("" ::: "memory");
        if (wc == 3) return;
        f32x4 g4[2][2];
#pragma unroll
        for (int bj = 0; bj < 2; ++bj)
#pragma unroll
            for (int n = 0; n < 2; ++n) g4[bj][n] = *(const f32x4*)(gq + wc * 64 + bj * 32 + 8 * fq + 4 * n);
#pragma unroll
        for (int ai = 0; ai < 2; ++ai)
#pragma unroll
            for (int m = 0; m < 4; ++m) { asm volatile("" ::: "memory");
                const int lrow = EPI_ROWS(ai, m), grow = row0 + lrow;
                const f32x4 pp = *(const LAS f32x4*)(scr + (ai * 128 + wr * 64 + m * 16 + fr) * 4);
                const float rn = rsqrtf(((pp[0] + pp[1]) + pp[2]) * (1.f / 192.f) + EPS) * (0.07216878364870322f * LOG2E);
                f32x4 v[2][2];
#pragma unroll
                for (int bj = 0; bj < 2; ++bj)
#pragma unroll
                    for (int n = 0; n < 2; ++n) v[bj][n] = acc[ai][bj][m][n] * rn * g4[bj][n];
                if (wc == 2) { const int pos = tok_pos(grow);
#pragma unroll
                    for (int n = 0; n < 2; ++n) { const int i0 = 8 * fq + 4 * n; const f32x4 c = *(const f32x4*)(mcos + pos * 32 + i0), sn = *(const f32x4*)(msin + pos * 32 + i0);
                        const f32x4 a = v[0][n], b = v[1][n]; v[0][n] = a * c - b * sn; v[1][n] = b * c + a * sn; } }
                bf16_t* o = Q + (size_t)lrow * 1536 + h * 192 + wc * 64 + fq * 8;
                *(u32x4*)o = pack8(v[0][0], v[0][1]); *(u32x4*)(o + 32) = pack8(v[1][0], v[1][1]);
            }
    }
};
struct EpiKV {
    static constexpr bool PERM = true, AFTER_DRAIN = false;
    const float* SSQKV; const float* SSQPE; const float* KPE; const float* gk; bf16_t* K; bf16_t* V; LAS float* scr; int row0;
    __device__ __forceinline__ void operator()(AccRef acc, const Unit& u, int wr, int wc, int fr, int fq) const {
        asm volatile("" : "+v"(fr), "+v"(fq));
        const int h = u.pn;
#pragma unroll
        for (int ai = 0; ai < 2; ++ai)
#pragma unroll
            for (int m = 0; m < 4; ++m) { asm volatile("" ::: "memory");
                const int grow = row0 + EPI_ROWS(ai, m);
                const float rkv = rsqrtf(SSQKV[grow] * (1.f / 256.f) + EPS);
                float part = 0.f;
#pragma unroll
                for (int bj = 0; bj < 2; ++bj)
#pragma unroll
                    for (int n = 0; n < 2; ++n) { acc[ai][bj][m][n] = acc[ai][bj][m][n] * rkv; part += dot4(acc[ai][bj][m][n]); }
                part = quad_sum(part);
                if (fq == 0 && wc < 2) scr[(ai * 128 + wr * 64 + m * 16 + fr) * 2 + wc] = part;
            }
        asm volatile("s_waitcnt lgkmcnt(0)" ::: "memory"); __builtin_amdgcn_s_barrier(); asm volatile("" ::: "memory");
        float rn[2][4];
#pragma unroll
        for (int ai = 0; ai < 2; ++ai)
#pragma unroll
            for (int m = 0; m < 4; ++m) { const int grow = row0 + EPI_ROWS(ai, m); const int rl = ai * 128 + wr * 64 + m * 16 + fr;
                rn[ai][m] = rsqrtf((scr[rl * 2] + scr[rl * 2 + 1] + SSQPE[grow]) * (1.f / 192.f) + EPS); }
        if (wc < 2) {
#pragma unroll
            for (int bj = 0; bj < 2; ++bj) {
                const f32x4 g0 = *(const f32x4*)(gk + wc * 64 + bj * 32 + 8 * fq), g1 = *(const f32x4*)(gk + wc * 64 + bj * 32 + 8 * fq + 4);
#pragma unroll
                for (int ai = 0; ai < 2; ++ai)
#pragma unroll
                    for (int m = 0; m < 4; ++m) { const int lrow = EPI_ROWS(ai, m);
                        *(u32x4*)(K + (size_t)lrow * 1536 + h * 192 + wc * 64 + bj * 32 + fq * 8) = pack8(acc[ai][bj][m][0] * rn[ai][m] * g0, acc[ai][bj][m][1] * rn[ai][m] * g1); }
                asm volatile("" ::: "memory");
            }
        } else {
#pragma unroll
            for (int ai = 0; ai < 2; ++ai)
#pragma unroll
                for (int m = 0; m < 4; ++m) { asm volatile("" ::: "memory");
                    const int lrow = EPI_ROWS(ai, m), grow = row0 + lrow;
                    bf16_t* o = V + (size_t)lrow * 1024 + h * 128 + (wc - 2) * 64 + fq * 8;
                    *(u32x4*)o = pack8(acc[ai][0][m][0], acc[ai][0][m][1]); *(u32x4*)(o + 32) = pack8(acc[ai][1][m][0], acc[ai][1][m][1]);
                    const int j0 = (wc - 2) * 32 + fq * 8; const f32x4 k0 = *(const f32x4*)(KPE + (size_t)grow * 64 + j0), k1 = *(const f32x4*)(KPE + (size_t)grow * 64 + j0 + 4);
                    *(u32x4*)(K + (size_t)lrow * 1536 + h * 192 + 128 + j0) = pack8(k0 * rn[ai][m], k1 * rn[ai][m]); }
        }
    }
};
template <int MODE> struct EpiEW {
    static constexpr bool PERM = true, AFTER_DRAIN = false;
    const float* ssq16; const bf16_t* aux; int ldaux; bf16_t* out; int ldo;
    __device__ __forceinline__ void operator()(AccRef acc, const Unit& u, int wr, int wc, int fr, int fq) const {
        asm volatile("" : "+v"(fr), "+v"(fq));
#pragma unroll
        for (int ai = 0; ai < 2; ++ai)
#pragma unroll
            for (int m = 0; m < 4; ++m) { asm volatile("" ::: "memory");
                const int row = EPI_ROWS(ai, m); float rs = 1.f; if (MODE == 0 || MODE == 5) rs = rs16(ssq16, row);
#pragma unroll
                for (int bj = 0; bj < 2; ++bj) { const int col0 = u.pn * 256 + bj * 128 + wc * 32 + fq * 8; f32x4 v[2] = {acc[ai][bj][m][0], acc[ai][bj][m][1]};
                    if (MODE == 0 || MODE == 4) {
#pragma unroll
                        for (int n = 0; n < 2; ++n)
#pragma unroll
                            for (int e = 0; e < 4; ++e) v[n][e] = __builtin_amdgcn_rcpf(1.f + __builtin_amdgcn_exp2f(v[n][e] * (-rs * LOG2E)));
                    } else if (MODE == 5) { v[0] = v[0] * rs; v[1] = v[1] * rs;
                    } else if (MODE == 1 || MODE == 2) {
                        const u32x4 g = *(const u32x4*)(aux + (size_t)row * ldaux + col0);
                        const f32x4 ga = {bf_lo(g.x), bf_hi(g.x), bf_lo(g.y), bf_hi(g.y)}, gb = {bf_lo(g.z), bf_hi(g.z), bf_lo(g.w), bf_hi(g.w)};
                        v[0] = v[0] * ga; v[1] = v[1] * gb;
                        if (MODE == 2) { const u32x4 p = *(const u32x4*)(out + (size_t)row * ldo + col0);
                            v[0] = v[0] + (f32x4){bf_lo(p.x), bf_hi(p.x), bf_lo(p.y), bf_hi(p.y)}; v[1] = v[1] + (f32x4){bf_lo(p.z), bf_hi(p.z), bf_lo(p.w), bf_hi(p.w)}; }
                    }
                    *(u32x4*)(out + (size_t)row * ldo + col0) = pack8(v[0], v[1]); }
            }
    }
};
struct EpiFinal {
    static constexpr bool PERM = true, AFTER_DRAIN = false;
    const float* ssq16; const bf16_t* pe; const bf16_t* xb; float* out;
    __device__ __forceinline__ void operator()(AccRef acc, const Unit& u, int wr, int wc, int fr, int fq) const {
        asm volatile("" : "+v"(fr), "+v"(fq));
#pragma unroll
        for (int ai = 0; ai < 2; ++ai)
#pragma unroll
            for (int m = 0; m < 4; ++m) { asm volatile("" ::: "memory");
                const int row = EPI_ROWS(ai, m); const float rs = rs16(ssq16, row);
#pragma unroll
                for (int bj = 0; bj < 2; ++bj) { const int col0 = u.pn * 256 + bj * 128 + wc * 32 + fq * 8;
                    const u32x4 g = *(const u32x4*)(pe + (size_t)row * DM + col0), p = *(const u32x4*)(xb + (size_t)row * DM + col0);
                    const f32x4 pa = {bf_lo(g.x), bf_hi(g.x), bf_lo(g.y), bf_hi(g.y)}, pb = {bf_lo(g.z), bf_hi(g.z), bf_lo(g.w), bf_hi(g.w)};
                    f32x4 x0 = {bf_lo(p.x), bf_hi(p.x), bf_lo(p.y), bf_hi(p.y)}, x1 = {bf_lo(p.z), bf_hi(p.z), bf_lo(p.w), bf_hi(p.w)};
                    float* o = out + (size_t)row * DM + col0;
#pragma unroll
                    for (int e = 0; e < 4; ++e) { x0[e] += __builtin_amdgcn_rcpf(1.f + __builtin_amdgcn_exp2f(acc[ai][bj][m][0][e] * (-rs * LOG2E))) * pa[e]; x1[e] += __builtin_amdgcn_rcpf(1.f + __builtin_amdgcn_exp2f(acc[ai][bj][m][1][e] * (-rs * LOG2E))) * pb[e]; }
                    *(f32x4*)o = x0; *(f32x4*)(o + 4) = x1; }
            }
    }
};

template <class E> __device__ __forceinline__ void run_gemm(LAS unsigned char* lds, const bf16_t* A, const bf16_t* Bt, int M, int N, int K, const E& e) {
    asm volatile("" : "+s"(K));
    A = (const bf16_t*)uniform_ptr(A); Bt = (const bf16_t*)uniform_ptr(Bt);
    pg8::Gemm g{A, Bt, M, N, K}; pg8::StaticOrder S; S.init(M, N, (int)gridDim.x, (int)blockIdx.x);
    pg8::gemm_phase<E, pg8::StaticOrder, true, true>(lds, g, S, e);
}

struct WDesc { const float* src; const float* src2; const float* gain; bf16_t* dst; int K, Nsrc, Ndst, map; };
__device__ __forceinline__ int wcolmap(int map, int n, int& which) {
    which = 0;
    const int tp = n & 255, bj = tp >> 7, wc = (tp >> 5) & 3, c = tp & 31;
    switch (map) {
    case 0: return n;
    case 1: which = bj; return (n >> 8) * 128 + (tp & 127);
    case 2: { const int g = n / 1536, nn = n - g * 1536, pn = nn >> 8, s = pn >> 1, hh = pn & 1, h = hh * 4 + wc, p = bj * 32 + c;
              const int d = (s < 2 && p < 16) ? (4 * (p >> 3) + 8 * ((p >> 2) & 1) + (p & 3)) : p; return 832 + g * 1536 + s * 512 + h * 64 + d; }
    case 3: { if (n < 768) return n; const int t = n - 768; if (t < 32) return 768 + t; if (t >= 128 && t < 160) return 800 + (t - 128); return -1; }
    case 4: { if (wc == 3) return -1; return (n >> 8) * 192 + wc * 64 + bj * 32 + c; }
    case 5: { const int h = n >> 8; return wc < 2 ? h * 256 + wc * 64 + bj * 32 + c : h * 256 + 128 + (wc - 2) * 64 + bj * 32 + c; }
    case 6: return 5440 + n;
    }
    return -1;
}
__device__ __forceinline__ void transpose_item(const WDesc& d, LAS float* scr, int item, int lane) {
    const int nblk = d.Ndst / 32, kb = item / nblk, nb = item - kb * nblk, k0 = 64 * kb, n0 = 32 * nb;
    int which; const int col = wcolmap(d.map, n0 + (lane & 31), which); const bool up = (d.map == 1) && (((n0 >> 7) & 1) != 0); const float* src = (const float*)uniform_ptr(up ? d.src2 : d.src);
    float tv[32];
#pragma unroll
    for (int i = 0; i < 32; ++i) { const int kk = 2 * i + (lane >> 5); float v = 0.f; if (col >= 0) { v = src[(size_t)(k0 + kk) * d.Nsrc + col]; } tv[i] = v; }
#pragma unroll
    for (int i = 0; i < 32; ++i) { const int kk = 2 * i + (lane >> 5); float v = tv[i]; if (d.gain) v *= d.gain[k0 + kk]; scr[kk * 33 + (lane & 31)] = v; }
    asm volatile("s_waitcnt lgkmcnt(0)" ::: "memory");
    const int c = lane & 7;
#pragma unroll
    for (int j = 0; j < 4; ++j) { const int n = (lane >> 3) + 8 * j; const LAS float* s = scr + (8 * c) * 33 + n;
        u32x4 o; o.x = cvt_pk_bf16(s[0 * 33], s[1 * 33]); o.y = cvt_pk_bf16(s[2 * 33], s[3 * 33]); o.z = cvt_pk_bf16(s[4 * 33], s[5 * 33]); o.w = cvt_pk_bf16(s[6 * 33], s[7 * 33]);
        *(u32x4*)(d.dst + (size_t)(n0 + n) * d.K + k0 + 8 * c) = o; }
    asm volatile("s_waitcnt lgkmcnt(0)" ::: "memory");
}
__device__ __forceinline__ float wave_sum(float v) {
#pragma unroll
    for (int o = 1; o < 64; o <<= 1) v += __shfl_xor(v, o);
    return v;
}
__device__ __forceinline__ void prologue(CParams& P, LAS unsigned char* lds) {
    int tid_ = threadIdx.x; asm volatile("" : "+v"(tid_));
    const int tid = tid_, lane = tid & 63, wave = tid >> 6; const int gw = blockIdx.x * 8 + wave, NGW = gridDim.x * 8;
    LAS float* scr = (LAS float*)(lds + wave * 16384);
    int base = 0; unsigned char* ws = P.ws;
#define WCONV(SRC, SRC2, GAIN, DSTOFF, KK, NSRC, NDST, MAP) { const WDesc d{SRC, SRC2, GAIN, (bf16_t*)(ws + (DSTOFF)), KK, NSRC, NDST, MAP}; constexpr int items = ((KK) / 64) * ((NDST) / 32); \
        for (int it = (gw - base % NGW + NGW) % NGW; it < items; it += NGW) transpose_item(d, scr, it, lane); base += items; asm volatile("" ::: "memory"); }
    WCONV(P.in[5], P.in[6], P.in[4], W_GU1, 1024, 2816, 5632, 1)
    WCONV(P.in[7], nullptr, nullptr, W_D1, 2816, 1024, 1024, 0)
    WCONV(P.in[22], P.in[23], P.in[21], W_GU2, 1024, 2816, 5632, 1)
    WCONV(P.in[24], nullptr, nullptr, W_D2, 2816, 1024, 1024, 0)
    WCONV(P.in[9], nullptr, P.in[8], W_DIL, 1024, 7488, 4608, 2)
    WCONV(P.in[9], nullptr, P.in[8], W_A, 1024, 7488, 1024, 3)
    WCONV(P.in[11], nullptr, P.in[10], W_UQ, 512, 1536, 2048, 4)
    WCONV(P.in[13], nullptr, P.in[12], W_UKV, 256, 2048, 2048, 5)
    WCONV(P.in[9], nullptr, P.in[8], W_G, 1024, 7488, 2048, 6)
    WCONV(P.in[18], nullptr, nullptr, W_OA, 1024, 1024, 1024, 0)
    WCONV(P.in[19], nullptr, nullptr, W_OB, 512, 1024, 1024, 0)
    WCONV(P.in[20], nullptr, nullptr, W_OUT, 1024, 1024, 1024, 0)
    WCONV(P.in[27], nullptr, P.in[25], W_PG, 1024, 1024, 1024, 0)
    WCONV(P.in[26], nullptr, nullptr, W_PE, 256, 1024, 1024, 0)
#undef WCONV
    bf16_t* XB = (bf16_t*)(P.ws + XB_OFF); float* RS0 = (float*)(P.ws + S_RS0);
    for (int m = gw; m < T; m += NGW) { const float* xr = m < TP ? P.in[0] + (size_t)m * DM : P.in[1] + (size_t)(m - TP) * DM;
        f32x4 v[4]; float s = 0.f;
#pragma unroll
        for (int j = 0; j < 4; ++j) { v[j] = ((const f32x4*)xr)[lane + 64 * j]; s += dot4(v[j]); }
        s = wave_sum(s);
#pragma unroll
        for (int j = 0; j < 4; ++j) { u32x2 w; w.x = cvt_pk_bf16(v[j][0], v[j][1]); w.y = cvt_pk_bf16(v[j][2], v[j][3]); ((u32x2*)(XB + (size_t)m * DM))[lane + 64 * j] = w; }
        if (lane == 0) RS0[m] = rsqrtf(s * (1.f / 1024.f) + EPS); }
    float* mcos = (float*)(P.ws + S_MCOS); float* msin = (float*)(P.ws + S_MSIN); float* dcos = (float*)(P.ws + S_DCOS); float* dsin = (float*)(P.ws + S_DSIN);
    const int gt = blockIdx.x * 512 + tid, NT = gridDim.x * 512;
    for (int i = gt; i < 16384 * 40; i += NT) { const bool big = i < 16384 * 32; const int j = big ? i : i - 16384 * 32; const int pos = big ? (j >> 5) : (j >> 3), f = big ? (j & 31) : (j & 7);
        const double inv = exp2(-18.931568569324174 * (double)f / (big ? 32.0 : 8.0)); double xr = (double)pos * inv * 0.15915494309189535; xr -= floor(xr); const float rev = (float)xr;
        const float cs = __builtin_amdgcn_cosf(rev), sn = __builtin_amdgcn_sinf(rev);
        if (big) { mcos[j] = cs; msin[j] = sn; } else { dcos[j] = cs; dsin[j] = sn; } }
}

__device__ __forceinline__ bf16x8 vtr8(const LAS unsigned char* lo, const LAS unsigned char* hi) {
    const v4i16_t a = __builtin_amdgcn_ds_read_tr16_b64_v4i16((LAS v4i16_t*)lo), b = __builtin_amdgcn_ds_read_tr16_b64_v4i16((LAS v4i16_t*)hi);
    return (bf16x8){a[0], a[1], a[2], a[3], b[0], b[1], b[2], b[3]};
}
constexpr int MLA_KP = 400, MLA_KB = 64 * MLA_KP, MLA_VB = 16384, MLA_VOFF = 3 * MLA_KB;
__device__ __forceinline__ void mla_unit(LAS unsigned char* lds, const bf16_t* Qg, const bf16_t* Kg, const bf16_t* Vg, bf16_t* Og, int qrow0, int krow0, int nkt, int h, size_t orow0) {
    int tid_ = threadIdx.x; asm volatile("" : "+v"(tid_));
    const int tid = tid_, lane = tid & 63, wave = tid >> 6, l31 = lane & 31, hi = lane >> 5;
    bf16x8 qf[12];
    { const bf16_t* qp = Qg + (size_t)(qrow0 + wave * 32 + l31) * 1536 + h * 192 + hi * 8;
#pragma unroll
      for (int ks = 0; ks < 12; ++ks) qf[ks] = *(const bf16x8*)(qp + ks * 16); }
    const int skey = tid >> 3, sc8 = tid & 7;
    const bf16_t* kbase = Kg + (size_t)(krow0 + skey) * 1536 + h * 192 + sc8 * 8; const bf16_t* vbase = Vg + (size_t)(krow0 + skey) * 1024 + h * 128 + sc8 * 8;
    const int klds = skey * MLA_KP + sc8 * 16, vlds = MLA_VOFF + ((skey >> 3) * 4 + (sc8 >> 2)) * 512 + (skey & 7) * 64 + (sc8 & 3) * 16;
    u32x4 kr[3], vr[2];
#define MLA_LOADK(t) do { _Pragma("unroll") for (int i = 0; i < 3; ++i) kr[i] = *(const u32x4*)(kbase + (size_t)(t) * (64 * 1536) + i * 64); } while (0)
#define MLA_LOADV(t) do { _Pragma("unroll") for (int i = 0; i < 2; ++i) vr[i] = *(const u32x4*)(vbase + (size_t)(t) * (64 * 1024) + i * 64); } while (0)
#define MLA_STOREK(off) do { _Pragma("unroll") for (int i = 0; i < 3; ++i) *(LAS u32x4*)(lds + (off) + klds + i * 128) = kr[i]; } while (0)
#define MLA_STOREV(off) do { _Pragma("unroll") for (int i = 0; i < 2; ++i) *(LAS u32x4*)(lds + (off) + vlds + i * 1024) = vr[i]; } while (0)
    f32x16 O[4];
#pragma unroll
    for (int dt = 0; dt < 4; ++dt)
#pragma unroll
        for (int r = 0; r < 16; ++r) O[dt][r] = 0.f;
    float mrun = -INFINITY, lrun = 0.f;
    const int koff = l31 * MLA_KP + hi * 16;
    const int voff = MLA_VOFF + (4 * hi + ((lane & 15) >> 2)) * 64 + (((lane >> 4) & 1) * 16 + (lane & 3) * 4) * 2;
    f32x16 sa0, sa1, sb0, sb1; bf16x8 pf[4];
#define MLA_QK(S0, S1, KOFF) do { const LAS unsigned char* sb_ = lds + (KOFF); \
        _Pragma("unroll") for (int r = 0; r < 16; ++r) { S0[r] = 0.f; S1[r] = 0.f; } \
        bf16x8 kq[2][2]; \
        kq[0][0] = *(const LAS bf16x8*)(sb_ + koff); kq[0][1] = *(const LAS bf16x8*)(sb_ + koff + 32 * MLA_KP); \
        _Pragma("unroll") for (int ks = 0; ks < 12; ++ks) { \
            if (ks < 11) { kq[(ks + 1) & 1][0] = *(const LAS bf16x8*)(sb_ + koff + (ks + 1) * 32); kq[(ks + 1) & 1][1] = *(const LAS bf16x8*)(sb_ + koff + 32 * MLA_KP + (ks + 1) * 32); } \
            S0 = __builtin_amdgcn_mfma_f32_32x32x16_bf16(kq[ks & 1][0], qf[ks], S0, 0, 0, 0); S1 = __builtin_amdgcn_mfma_f32_32x32x16_bf16(kq[ks & 1][1], qf[ks], S1, 0, 0, 0); } } while (0)
#define MLA_SM(S0, S1) do { float mx = fmaxf(S0[0], S1[0]); \
        _Pragma("unroll") for (int r = 1; r < 16; ++r) mx = fmaxf(mx, fmaxf(S0[r], S1[r])); \
        { const auto rr_ = __builtin_amdgcn_permlane32_swap(__float_as_uint(mx), __float_as_uint(mx), false, false); mx = fmaxf(__uint_as_float(rr_[0]), __uint_as_float(rr_[1])); } \
        if (__any(mx > mrun)) { const float mnew = fmaxf(mrun, mx), alpha = __builtin_amdgcn_exp2f(mrun - mnew); mrun = mnew; lrun *= alpha; \
            _Pragma("unroll") for (int dt = 0; dt < 4; ++dt) _Pragma("unroll") for (int r = 0; r < 16; ++r) O[dt][r] *= alpha; } \
        float ls = 0.f; \
        _Pragma("unroll") for (int r = 0; r < 16; ++r) { S0[r] = __builtin_amdgcn_exp2f(S0[r] - mrun); S1[r] = __builtin_amdgcn_exp2f(S1[r] - mrun); ls += S0[r] + S1[r]; } \
        lrun += ls; \
        _Pragma("unroll") for (int j = 0; j < 2; ++j) { u32x4 w0, w1; \
            w0.x = cvt_pk_bf16(S0[8 * j + 0], S0[8 * j + 1]); w0.y = cvt_pk_bf16(S0[8 * j + 2], S0[8 * j + 3]); w0.z = cvt_pk_bf16(S0[8 * j + 4], S0[8 * j + 5]); w0.w = cvt_pk_bf16(S0[8 * j + 6], S0[8 * j + 7]); \
            w1.x = cvt_pk_bf16(S1[8 * j + 0], S1[8 * j + 1]); w1.y = cvt_pk_bf16(S1[8 * j + 2], S1[8 * j + 3]); w1.z = cvt_pk_bf16(S1[8 * j + 4], S1[8 * j + 5]); w1.w = cvt_pk_bf16(S1[8 * j + 6], S1[8 * j + 7]); \
            pf[j] = __builtin_bit_cast(bf16x8, w0); pf[2 + j] = __builtin_bit_cast(bf16x8, w1); } } while (0)
#define MLA_PV(VOFFB) do { const LAS unsigned char* sb_ = lds + (VOFFB); bf16x8 vq[2][2]; \
        vq[0][0] = vtr8(sb_ + voff, sb_ + voff + 4 * 512); vq[0][1] = vtr8(sb_ + voff + 512, sb_ + voff + 5 * 512); \
        _Pragma("unroll") for (int st = 0; st < 8; ++st) { const int kg = st >> 1, dp = st & 1; \
            if (st < 7) { const int kg2 = (st + 1) >> 1, dp2 = (st + 1) & 1; \
                vq[(st + 1) & 1][0] = vtr8(sb_ + voff + ((2 * kg2) * 4 + 2 * dp2) * 512, sb_ + voff + ((2 * kg2 + 1) * 4 + 2 * dp2) * 512); \
                vq[(st + 1) & 1][1] = vtr8(sb_ + voff + ((2 * kg2) * 4 + 2 * dp2 + 1) * 512, sb_ + voff + ((2 * kg2 + 1) * 4 + 2 * dp2 + 1) * 512); } \
            O[2 * dp] = __builtin_amdgcn_mfma_f32_32x32x16_bf16(vq[st & 1][0], pf[kg], O[2 * dp], 0, 0, 0); \
            O[2 * dp + 1] = __builtin_amdgcn_mfma_f32_32x32x16_bf16(vq[st & 1][1], pf[kg], O[2 * dp + 1], 0, 0, 0); } } while (0)
#define MLA_STEP(t, SC0, SC1, SN0, SN1) do { const bool more1 = ((t) + 1 < nkt), more2 = ((t) + 2 < nkt); \
        if (more1) { MLA_QK(SN0, SN1, k_nxt); } \
        if (more2) MLA_LOADK((t) + 2); \
        MLA_SM(SC0, SC1); \
        if (more1) MLA_LOADV((t) + 1); \
        MLA_PV(((t) & 1) * MLA_VB); \
        if (more2) MLA_STOREK(k_prv); \
        if (more1) MLA_STOREV((((t) + 1) & 1) * MLA_VB); \
        __syncthreads(); \
        { const int tmp_ = k_prv; k_prv = k_cur; k_cur = k_nxt; k_nxt = tmp_; } } while (0)
    { u32x4 k1r[3];
      MLA_LOADK(0); MLA_LOADV(0);
#pragma unroll
      for (int i = 0; i < 3; ++i) k1r[i] = *(const u32x4*)(kbase + (size_t)(64 * 1536) + i * 64);
      MLA_STOREK(0); MLA_STOREV(0);
#pragma unroll
      for (int i = 0; i < 3; ++i) *(LAS u32x4*)(lds + MLA_KB + klds + i * 128) = k1r[i]; }
    __syncthreads();
    int k_cur = 0, k_nxt = MLA_KB, k_prv = 2 * MLA_KB;
    MLA_QK(sa0, sa1, k_cur);
    for (int t = 0; t < nkt; t += 2) {
        MLA_STEP(t, sa0, sa1, sb0, sb1);
        MLA_STEP(t + 1, sb0, sb1, sa0, sa1);
    }
    lrun += __shfl_xor(lrun, 32);
    const float inv = 1.f / lrun;
    bf16_t* op = Og + (orow0 + wave * 32 + l31) * 1024 + h * 128 + 4 * hi;
#pragma unroll
    for (int dt = 0; dt < 4; ++dt)
#pragma unroll
        for (int a = 0; a < 4; ++a) { u32x2 w; w.x = cvt_pk_bf16(O[dt][4 * a] * inv, O[dt][4 * a + 1] * inv); w.y = cvt_pk_bf16(O[dt][4 * a + 2] * inv, O[dt][4 * a + 3] * inv);
            *(u32x2*)(op + dt * 32 + a * 8) = w; }
#undef MLA_LOADK
#undef MLA_LOADV
#undef MLA_STOREK
#undef MLA_STOREV
#undef MLA_QK
#undef MLA_SM
#undef MLA_PV
#undef MLA_STEP
}
__device__ __forceinline__ void mla_phase(LAS unsigned char* lds, CParams& P, int chunk) {
    const bf16_t* Qg = (const bf16_t*)(P.ws + R_Q); const bf16_t* Kg = (const bf16_t*)(P.ws + R_K); const bf16_t* Vg = (const bf16_t*)(P.ws + R_V); bf16_t* Og = (bf16_t*)(P.ws + R_OM);
    const int G = gridDim.x, nbig = chunk == 0 ? 512 : 0, ntot = 1280;
    for (int idx = blockIdx.x; idx < ntot; idx += G) {
        int h, qrow0, krow0, nkt;
        if (idx < nbig) { h = idx & 7; krow0 = 0; qrow0 = (idx >> 3) * 256; nkt = 256; }
        else { const int s = idx - nbig; h = s & 7; const int qb = (s >> 3) & 7, seq = s >> 6; krow0 = (chunk == 0 ? TP : 0) + seq * SS; qrow0 = krow0 + qb * 256; nkt = 32; }
        mla_unit(lds, Qg, Kg, Vg, Og, qrow0, krow0, nkt, h, (size_t)chunk * CH + qrow0);
    }
}

__device__ __forceinline__ void dil_phase(LAS unsigned char* lds, CParams& P, int g) {
    const bf16_t* DIL = (const bf16_t*)(P.ws + R_DIL);
    const int sh = 2 * g, dmask = (1 << sh) - 1;
    int tid_ = threadIdx.x; asm volatile("" : "+v"(tid_));
    const int tid = tid_, lane = tid & 63, wave = tid >> 6, hb = wave >> 2, w = wave & 3, tl = tid & 255, l31 = lane & 31, hi = lane >> 5;
    LAS unsigned char* vb = lds + hb * 32768;
    const int voff = (4 * hi + ((lane & 15) >> 2)) * 64 + (((lane >> 4) & 1) * 16 + (lane & 3) * 4) * 2;
    u32x4 vr[8];
#define DIL_VLOAD(BU) do { const int su_ = 2 * (BU) + hb; int t0_, S_, loc_; \
        if (su_ < 1024) { t0_ = 0; S_ = TP; loc_ = su_; } else { const int s_ = (su_ - 1024) >> 7; t0_ = TP + s_ * SS; S_ = SS; loc_ = (su_ - 1024) & 127; } \
        const int h_ = loc_ & 7, rest_ = loc_ >> 3, r_ = rest_ & dmask, qb_ = rest_ >> sh, L_ = S_ >> sh, subb_ = 128 * qb_ - 64; \
        _Pragma("unroll") for (int i = 0; i < 8; ++i) { const int c = tl + 256 * i, key = c >> 3, ch = c & 7; int sub = subb_ + key; sub = sub < 0 ? 0 : (sub > L_ - 1 ? L_ - 1 : sub); \
            vr[i] = *(const u32x4*)(DIL + (size_t)(t0_ + (sub << sh) + r_) * 1536 + 1024 + h_ * 64 + ch * 8); } } while (0)
    if ((int)blockIdx.x < 2560) DIL_VLOAD((int)blockIdx.x);
    for (int bu = blockIdx.x; bu < 2560; bu += gridDim.x) {
        const int su = 2 * bu + hb; int t0, S, loc;
        if (su < 1024) { t0 = 0; S = TP; loc = su; } else { const int s = (su - 1024) >> 7; t0 = TP + s * SS; S = SS; loc = (su - 1024) & 127; }
        const int h = loc & 7, rest = loc >> 3, r = rest & dmask, qb = rest >> sh, L = S >> sh, sub_b = 128 * qb - 64;
#pragma unroll
        for (int i = 0; i < 8; ++i) { const int c = tl + 256 * i, key = c >> 3, ch = c & 7; *(LAS u32x4*)(vb + ((key >> 3) * 2 + (ch >> 2)) * 512 + (key & 7) * 64 + (ch & 3) * 16) = vr[i]; }
        asm volatile("" ::: "memory");
        const int qsub = 128 * qb + 32 * w + l31; const size_t tokq = (size_t)(t0 + (qsub << sh) + r);
        bf16x8 qf[4];
#pragma unroll
        for (int ks = 0; ks < 4; ++ks) qf[ks] = *(const bf16x8*)(DIL + tokq * 1536 + h * 64 + ks * 16 + hi * 8);
        f32x16 sc[5];
        bf16x8 kfr[5][4];
#pragma unroll
        for (int kt = 0; kt < 5; ++kt) { int sub = sub_b + 32 * w + 32 * kt + l31; sub = sub < 0 ? 0 : (sub > L - 1 ? L - 1 : sub);
            const bf16_t* kp = DIL + (size_t)(t0 + (sub << sh) + r) * 1536 + 512 + h * 64 + hi * 8;
#pragma unroll
            for (int ks = 0; ks < 4; ++ks) kfr[kt][ks] = *(const bf16x8*)(kp + ks * 16); }
        if (bu + (int)gridDim.x < 2560) DIL_VLOAD(bu + (int)gridDim.x);
#pragma unroll
        for (int kt = 0; kt < 5; ++kt) {
#pragma unroll
            for (int r2 = 0; r2 < 16; ++r2) sc[kt][r2] = 0.f;
#pragma unroll
            for (int ks = 0; ks < 4; ++ks) sc[kt] = __builtin_amdgcn_mfma_f32_32x32x16_bf16(kfr[kt][ks], qf[ks], sc[kt], 0, 0, 0);
        }
        float mx = -INFINITY;
#pragma unroll
        for (int kt = 0; kt < 5; ++kt)
#pragma unroll
            for (int r2 = 0; r2 < 16; ++r2) { const int keyl = (r2 & 3) + 8 * (r2 >> 2) + 4 * hi; const int rel = -64 + 32 * kt + keyl - l31; const int ksub = sub_b + 32 * w + 32 * kt + keyl;
                const bool ok = (rel >= -64) && (rel <= 64) && (ksub >= 0) && (ksub < L); sc[kt][r2] = ok ? sc[kt][r2] : -INFINITY; mx = fmaxf(mx, sc[kt][r2]); }
        mx = fmaxf(mx, __shfl_xor(mx, 32));
        float ls = 0.f;
#pragma unroll
        for (int kt = 0; kt < 5; ++kt)
#pragma unroll
            for (int r2 = 0; r2 < 16; ++r2) { sc[kt][r2] = __builtin_amdgcn_exp2f(sc[kt][r2] - mx); ls += sc[kt][r2]; }
        ls += __shfl_xor(ls, 32);
        __syncthreads();
        f32x16 O[2];
#pragma unroll
        for (int dt = 0; dt < 2; ++dt)
#pragma unroll
            for (int r2 = 0; r2 < 16; ++r2) O[dt][r2] = 0.f;
#pragma unroll
        for (int kt = 0; kt < 5; ++kt)
#pragma unroll
            for (int j = 0; j < 2; ++j) {
                u32x4 pw; pw.x = cvt_pk_bf16(sc[kt][8 * j + 0], sc[kt][8 * j + 1]); pw.y = cvt_pk_bf16(sc[kt][8 * j + 2], sc[kt][8 * j + 3]); pw.z = cvt_pk_bf16(sc[kt][8 * j + 4], sc[kt][8 * j + 5]); pw.w = cvt_pk_bf16(sc[kt][8 * j + 6], sc[kt][8 * j + 7]);
                const bf16x8 pf = __builtin_bit_cast(bf16x8, pw); const int kg = 2 * w + 2 * kt + j;
#pragma unroll
                for (int dt = 0; dt < 2; ++dt) { const bf16x8 vf = vtr8(vb + voff + ((2 * kg) * 2 + dt) * 512, vb + voff + ((2 * kg + 1) * 2 + dt) * 512);
                    O[dt] = __builtin_amdgcn_mfma_f32_32x32x16_bf16(vf, pf, O[dt], 0, 0, 0); }
            }
        const float inv = 1.f / ls, lse = mx + __builtin_amdgcn_logf(ls);
        if (g < 2) { bf16_t* Og = (bf16_t*)(P.ws + (g == 0 ? R_O0 : R_O1)); float* Lg = (float*)(P.ws + (g == 0 ? S_L0 : S_L1));
#pragma unroll
            for (int dt = 0; dt < 2; ++dt)
#pragma unroll
                for (int a = 0; a < 4; ++a) { u32x2 wv; wv.x = cvt_pk_bf16(O[dt][4 * a] * inv, O[dt][4 * a + 1] * inv); wv.y = cvt_pk_bf16(O[dt][4 * a + 2] * inv, O[dt][4 * a + 3] * inv);
                    *(u32x2*)(Og + tokq * 512 + h * 64 + dt * 32 + a * 8 + 4 * hi) = wv; }
            if (hi == 0) Lg[(size_t)h * T + t0 + r * L + qsub] = lse;
        } else { bf16_t* Og = (bf16_t*)(P.ws + R_OD); const bf16_t* O0 = (const bf16_t*)(P.ws + R_O0); const bf16_t* O1 = (const bf16_t*)(P.ws + R_O1); const float* L0 = (const float*)(P.ws + S_L0); const float* L1 = (const float*)(P.ws + S_L1);
            const int pos = (qsub << sh) + r; const float l0 = L0[(size_t)h * T + t0 + pos], l1 = L1[(size_t)h * T + t0 + (pos & 3) * (S >> 2) + (pos >> 2)]; const float mm = fmaxf(fmaxf(l0, l1), lse);
            float w0 = __builtin_amdgcn_exp2f(l0 - mm), w1 = __builtin_amdgcn_exp2f(l1 - mm), w2 = __builtin_amdgcn_exp2f(lse - mm); const float wi = 1.f / (w0 + w1 + w2);
            w0 *= wi; w1 *= wi; w2 *= wi * inv;
#pragma unroll
            for (int dt = 0; dt < 2; ++dt)
#pragma unroll
                for (int a = 0; a < 4; ++a) { const size_t off = tokq * 512 + h * 64 + dt * 32 + a * 8 + 4 * hi; const u32x2 a0 = *(const u32x2*)(O0 + off), a1 = *(const u32x2*)(O1 + off);
                    const float o0 = w0 * bf_lo(a0.x) + w1 * bf_lo(a1.x) + w2 * O[dt][4 * a], o1 = w0 * bf_hi(a0.x) + w1 * bf_hi(a1.x) + w2 * O[dt][4 * a + 1],
                                o2 = w0 * bf_lo(a0.y) + w1 * bf_lo(a1.y) + w2 * O[dt][4 * a + 2], o3 = w0 * bf_hi(a0.y) + w1 * bf_hi(a1.y) + w2 * O[dt][4 * a + 3];
                    u32x2 wv; wv.x = cvt_pk_bf16(o0, o1); wv.y = cvt_pk_bf16(o2, o3); *(u32x2*)(Og + off) = wv; }
        }
        __syncthreads();
    }
}


#define XB_TMO      128
#define XB_XCNT(j)  (256  + 64 * (j))
#define XB_XSUB(j)  (1280 + 64 * (j))
#define XB_XGEN(j)  (2304 + 64 * (j))
#define XB_TOP      3328
#define XB_TOPGEN   3392
#define XCD_BAR_WORDS 3456
#define XB_SPIN_CAP (1u << 28)

__device__ __forceinline__ unsigned xb_ld(unsigned* p)              { return __hip_atomic_load(p, __ATOMIC_RELAXED, __HIP_MEMORY_SCOPE_AGENT); }
__device__ __forceinline__ unsigned xb_add(unsigned* p, unsigned v) { return __hip_atomic_fetch_add(p, v, __ATOMIC_RELAXED, __HIP_MEMORY_SCOPE_AGENT); }
__device__ __forceinline__ unsigned xb_xcc_id() { return (unsigned)__builtin_amdgcn_s_getreg((3 << 11) | 20) & 0xFu; }
#define XB_SPIN(cond, bar) do { unsigned _sp = 0; while (cond) { __builtin_amdgcn_s_sleep(1); \
    if ((++_sp & 255u) == 0u) { if (xb_ld(&(bar)[XB_TMO])) break; if (_sp > XB_SPIN_CAP) { atomicAdd(&(bar)[XB_TMO], 1u); break; } } } } while (0)

struct XcdBarrier {
    unsigned* bar; unsigned x;
    volatile LAS unsigned* st;
};

__device__ __forceinline__ XcdBarrier xcd_barrier_post(unsigned* bar, volatile LAS unsigned* st) {
    XcdBarrier b; b.bar = bar; b.x = xb_xcc_id(); b.st = st;
    if (threadIdx.x == 0) (void)xb_add(&bar[XB_XCNT(b.x)], 1u);
    return b;
}
__device__ __forceinline__ void xcd_barrier_complete(unsigned* bar, unsigned x, unsigned& nloc, unsigned& nx) {
    const unsigned G = gridDim.x * gridDim.y * gridDim.z;
    unsigned sum, cnt, mine, sp = 0u;
    for (;;) {
        sum = 0u; cnt = 0u; mine = 0u;
#pragma unroll
        for (unsigned j = 0; j < 16; ++j) { const unsigned c = xb_ld(&bar[XB_XCNT(j)]); sum += c; cnt += (c > 0u) ? 1u : 0u; mine = (j == x) ? c : mine; }
        if (sum == G) break;
        __builtin_amdgcn_s_sleep(1);
        if ((++sp & 255u) == 0u) { if (xb_ld(&bar[XB_TMO])) break; if (sp > XB_SPIN_CAP) { atomicAdd(&bar[XB_TMO], 1u); break; } }
    }
    nloc = mine > 0u ? mine : 1u; nx = cnt > 0u ? cnt : 1u;
}

__device__ __forceinline__ void xcd_barrier(const XcdBarrier& b) {
    asm volatile("s_waitcnt vmcnt(0)" ::: "memory");
    __syncthreads();
    if (threadIdx.x == 0) {
        unsigned* bar = b.bar;
        __builtin_amdgcn_s_waitcnt(0);
        unsigned nloc = b.st[0], nx = b.st[1];
        if (nloc == 0u) { xcd_barrier_complete(bar, b.x, nloc, nx); b.st[0] = nloc; b.st[1] = nx; }
        const unsigned old = xb_add(&bar[XB_XSUB(b.x)], 1u);
        const unsigned gen = old / nloc;
        if (old + 1u == (gen + 1u) * nloc) {
            __builtin_amdgcn_fence(__ATOMIC_RELEASE, "agent");
            asm volatile("s_waitcnt vmcnt(0)" ::: "memory");
            const unsigned og = xb_add(&bar[XB_TOP], 1u);
            const unsigned tg = og / nx;
            if (og + 1u == (tg + 1u) * nx) xb_add(&bar[XB_TOPGEN], 1u);
            else XB_SPIN(xb_ld(&bar[XB_TOPGEN]) == tg, bar);
            __builtin_amdgcn_fence(__ATOMIC_ACQUIRE, "");
            xb_add(&bar[XB_XGEN(b.x)], 1u);
            asm volatile("s_waitcnt vmcnt(0)" ::: "memory");
        } else {
            XB_SPIN(xb_ld(&bar[XB_XGEN(b.x)]) == gen, bar);
            __builtin_amdgcn_fence(__ATOMIC_ACQUIRE, "agent");
            asm volatile("s_waitcnt vmcnt(0)" ::: "memory");
        }
    }
    __syncthreads();
}


__device__ __forceinline__ void dbg_dump(float* out, const bf16_t* src, int ncols) {
    const size_t n = (size_t)T * ncols; const size_t gt = (size_t)blockIdx.x * 512 + threadIdx.x, NT = (size_t)gridDim.x * 512;
    for (size_t i = gt; i < n; i += NT) { const size_t row = i / ncols, c = i - row * ncols; out[row * DM + c] = bf_lo((unsigned)src[i]); }
}
#ifndef DBG_STOP
#define DBG_STOP 0
#endif
#undef DIL_VLOAD
#define FRESH() CParams& P = *pp; unsigned char* ws = P.ws; bf16_t* XB = (bf16_t*)(ws + XB_OFF); bf16_t* H = (bf16_t*)(ws + R_H); (void)XB; (void)H; \
    float* SSQ1 = (float*)(ws + S_SSQ1); float* SSQ2 = (float*)(ws + S_SSQ2); float* SSQ3 = (float*)(ws + S_SSQ3); (void)SSQ1; (void)SSQ2; (void)SSQ3; \
    const float* mcos = (const float*)(ws + S_MCOS); const float* msin = (const float*)(ws + S_MSIN); const float* dcos = (const float*)(ws + S_DCOS); const float* dsin = (const float*)(ws + S_DSIN); (void)mcos; (void)msin; (void)dcos; (void)dsin;
#define GSYNC() do { XcdBarrier xb_; xb_.bar = (unsigned*)(pp->ws + S_CTL); xb_.x = xb_xcc_id(); xb_.st = (volatile LAS unsigned*)(lds + LDS_SCR + 8192); xcd_barrier(xb_); asm volatile("" : "+s"(pp) :: "memory"); } while (0)
__global__ void __launch_bounds__(512) mega_fwd(Params Pbyval) {
    extern __shared__ __attribute__((aligned(16))) unsigned char lds_raw[];
    LAS unsigned char* lds = (LAS unsigned char*)lds_raw;
    LAS float* scr = (LAS float*)(lds + LDS_SCR);
    cg::grid_group grid = cg::this_grid();
    CParams* pp = (CParams*)__builtin_amdgcn_kernarg_segment_ptr();
    asm volatile("" : "+s"(pp) :: "memory");
    volatile LAS unsigned* xst = (volatile LAS unsigned*)(lds + LDS_SCR + 8192);
    if (threadIdx.x < 2) xst[threadIdx.x] = 0u;
    __syncthreads();
    (void)xcd_barrier_post((unsigned*)(pp->ws + S_CTL), xst);
    grid.sync();

    { FRESH(); prologue(P, lds); }
#ifdef PROBE_PROL2
    GSYNC();
    { FRESH(); prologue(P, lds); }
#endif
    GSYNC();
    { FRESH(); EpiSwiglu e{(const float*)(ws + S_RS0), nullptr, H}; run_gemm(lds, XB, (const bf16_t*)(ws + W_GU1), T, 5632, 1024, e); }
#ifdef PROBE_G1X2
    GSYNC();
    { FRESH(); EpiSwiglu e{(const float*)(ws + S_RS0), nullptr, H}; run_gemm(lds, XB, (const bf16_t*)(ws + W_GU1), T, 5632, 1024, e); }
#endif
    GSYNC();
    { FRESH(); EpiResid<false> e{P.in[0], P.in[1], XB, SSQ1, 0.5f, scr}; run_gemm(lds, H, (const bf16_t*)(ws + W_D1), T, 1024, FF, e); }
    GSYNC();
    if (DBG_STOP == 1) return;
    if (DBG_STOP == 11) { { FRESH(); EpiDil e{SSQ1, P.in[16], P.in[17], dcos, dsin, (bf16_t*)(ws + R_DIL)}; run_gemm(lds, XB, (const bf16_t*)(ws + W_DIL), T, 1536, 1024, e); }
        GSYNC();
        { FRESH(); const size_t gt = (size_t)blockIdx.x * 512 + threadIdx.x, NT = (size_t)gridDim.x * 512; const bf16_t* G = (const bf16_t*)(ws + R_DIL);
          for (size_t i = gt; i < (size_t)T * 1024; i += NT) { const size_t row = i >> 10, c = i & 1023; P.out[i] = bf_lo((unsigned)G[row * 1536 + c]) + bf_lo((unsigned)G[row * 1536 + 512 + c]); } } return; }
    for (int g = 0; g < ((DBG_STOP == 9 || DBG_STOP == 12) ? 0 : 3); ++g) {
        { FRESH(); EpiDil e{SSQ1, P.in[16] + g * 64, P.in[17] + g * 64, dcos, dsin, (bf16_t*)(ws + R_DIL)}; run_gemm(lds, XB, (const bf16_t*)(ws + W_DIL) + (size_t)g * 1536 * 1024, T, 1536, 1024, e); }
        GSYNC();
        { FRESH(); dil_phase(lds, P, g); }
#ifdef PROBE_DIL2
        GSYNC();
        { FRESH(); dil_phase(lds, P, g); }
#endif
        GSYNC();
    }
    if (DBG_STOP == 2) { FRESH(); dbg_dump(P.out, (const bf16_t*)(ws + R_OD), 512); return; }
    for (int c = 0; c < ((DBG_STOP == 9 || DBG_STOP == 12) ? 0 : 2); ++c) {
        const int row0 = c * CH;
        { FRESH(); EpiA e{SSQ1, (bf16_t*)(ws + R_CQ), (bf16_t*)(ws + R_CKV), (float*)(ws + S_SSQQ), (float*)(ws + S_SSQKV), (float*)(ws + S_SSQPE), (float*)(ws + S_KPE), P.in[15], mcos, msin, row0, scr};
          run_gemm(lds, XB + (size_t)row0 * DM, (const bf16_t*)(ws + W_A), CH, 1024, 1024, e); }
        GSYNC();
        { FRESH(); EpiQ e{(const float*)(ws + S_SSQQ), P.in[14], mcos, msin, (bf16_t*)(ws + R_Q), scr, row0}; run_gemm(lds, (const bf16_t*)(ws + R_CQ), (const bf16_t*)(ws + W_UQ), CH, 2048, 512, e); }
        { FRESH(); EpiKV e{(const float*)(ws + S_SSQKV), (const float*)(ws + S_SSQPE), (const float*)(ws + S_KPE), P.in[15], (bf16_t*)(ws + R_K), (bf16_t*)(ws + R_V), scr, row0};
          run_gemm(lds, (const bf16_t*)(ws + R_CKV), (const bf16_t*)(ws + W_UKV), CH, 2048, 256, e); }
        GSYNC();
        { FRESH(); mla_phase(lds, P, c); }
#ifdef PROBE_MLA2
        GSYNC();
        { FRESH(); mla_phase(lds, P, c); }
#endif
        GSYNC();
    }
    if (DBG_STOP == 3) { FRESH(); dbg_dump(P.out, (const bf16_t*)(ws + R_OM), 1024); return; }
#ifdef PROBE_BAR10
    for (int i = 0; i < 10; ++i) GSYNC();
#endif
    if (DBG_STOP == 12) { FRESH(); EpiEW<5> e{SSQ1, nullptr, 0, (bf16_t*)(ws + R_GATES), 2048}; run_gemm(lds, XB, (const bf16_t*)(ws + W_G), T, 2048, 1024, e); } else
    { FRESH(); EpiEW<0> e{SSQ1, nullptr, 0, (bf16_t*)(ws + R_GATES), 2048}; run_gemm(lds, XB, (const bf16_t*)(ws + W_G), T, 2048, 1024, e); }
#ifdef PROBE_P9X2
    GSYNC();
    { FRESH(); EpiEW<0> e{SSQ1, nullptr, 0, (bf16_t*)(ws + R_GATES), 2048}; run_gemm(lds, XB, (const bf16_t*)(ws + W_G), T, 2048, 1024, e); }
#endif
    GSYNC();
    if (DBG_STOP == 8 || DBG_STOP == 9 || DBG_STOP == 12) { FRESH(); const size_t gt = (size_t)blockIdx.x * 512 + threadIdx.x, NT = (size_t)gridDim.x * 512; const bf16_t* G = (const bf16_t*)(ws + R_GATES);
        for (size_t i = gt; i < (size_t)T * 1024; i += NT) { const size_t row = i >> 10, c = i & 1023; P.out[i] = bf_lo((unsigned)G[row * 2048 + c]) + bf_lo((unsigned)G[row * 2048 + 1024 + c]); } return; }
    { FRESH(); EpiEW<1> e{nullptr, (const bf16_t*)(ws + R_GATES), 2048, (bf16_t*)(ws + R_TT), 1024}; run_gemm(lds, (const bf16_t*)(ws + R_OM), (const bf16_t*)(ws + W_OA), T, 1024, 1024, e); }
    GSYNC();
    if (DBG_STOP == 6) { FRESH(); dbg_dump(P.out, (const bf16_t*)(ws + R_TT), 1024); return; }
    { FRESH(); EpiEW<2> e{nullptr, (const bf16_t*)(ws + R_GATES) + 1024, 2048, (bf16_t*)(ws + R_TT), 1024}; run_gemm(lds, (const bf16_t*)(ws + R_OD), (const bf16_t*)(ws + W_OB), T, 1024, 512, e); }
    GSYNC();
    if (DBG_STOP == 7) { FRESH(); dbg_dump(P.out, (const bf16_t*)(ws + R_TT), 1024); return; }
    { FRESH(); EpiResid<true> e{nullptr, nullptr, XB, SSQ2, 1.0f, scr}; run_gemm(lds, (const bf16_t*)(ws + R_TT), (const bf16_t*)(ws + W_OUT), T, 1024, 1024, e); }
    GSYNC();
    if (DBG_STOP == 4) return;
    { FRESH(); bf16_t* PB = (bf16_t*)(ws + R_PB); const int gt = blockIdx.x * 512 + threadIdx.x, NT = gridDim.x * 512;
      for (int i = gt; i < T * 64; i += NT) { const int row = i >> 6, c4 = i & 63; const float* pr = row < TP ? P.in[2] + (size_t)row * 256 : P.in[3] + (size_t)(row - TP) * 256;
          const f32x4 v = ((const f32x4*)pr)[c4]; u32x2 w; w.x = cvt_pk_bf16(v[0], v[1]); w.y = cvt_pk_bf16(v[2], v[3]); ((u32x2*)(PB + (size_t)row * 256))[c4] = w; } }
    { FRESH(); EpiSwiglu e{nullptr, SSQ2, H}; run_gemm(lds, XB, (const bf16_t*)(ws + W_GU2), T, 5632, 1024, e); }
    GSYNC();
    { FRESH(); EpiResid<true> e{nullptr, nullptr, XB, SSQ3, 0.5f, scr}; run_gemm(lds, H, (const bf16_t*)(ws + W_D2), T, 1024, FF, e); }
    { FRESH(); EpiEW<3> e{nullptr, nullptr, 0, (bf16_t*)(ws + R_PEO), 1024}; run_gemm(lds, (const bf16_t*)(ws + R_PB), (const bf16_t*)(ws + W_PE), T, 1024, 256, e); }
    GSYNC();
    if (DBG_STOP == 5) return;
    { FRESH(); EpiFinal e{SSQ3, (const bf16_t*)(ws + R_PEO), XB, P.out}; run_gemm(lds, XB, (const bf16_t*)(ws + W_PG), T, 1024, 1024, e); }
}

extern "C" void kernel_launch(void* const* d_in, const int* in_sizes, int n_in, void* d_out, int out_size, void* d_ws, size_t ws_size, hipStream_t stream) {
    static int grid = 0;
    if (grid == 0) {
        if (n_in != 28 || out_size != T * DM || ws_size < WS_NEED) { fprintf(stderr, "kernel_launch: unexpected shapes (n_in %d out %d ws %zu)\n", n_in, out_size, ws_size); grid = -1; return; }
        int dev = 0, cus = 0, per_cu = 0;
        hipGetDevice(&dev); hipDeviceGetAttribute(&cus, hipDeviceAttributeMultiprocessorCount, dev);
        hipFuncSetAttribute((const void*)mega_fwd, hipFuncAttributeMaxDynamicSharedMemorySize, LDS_BYTES);
        hipOccupancyMaxActiveBlocksPerMultiprocessor(&per_cu, (const void*)mega_fwd, 512, LDS_BYTES);
        if (per_cu < 1) per_cu = 1;
        grid = cus * 1;
        (void)hipGetLastError();
    }
    if (grid < 0) return;
    Params p{};
    for (int i = 0; i < 28; ++i) p.in[i] = (const float*)d_in[i];
    p.out = (float*)d_out; p.ws = (unsigned char*)d_ws;
    hipMemsetAsync((char*)d_ws + S_CTL, 0, CTL_BYTES, stream);
    void* args[] = {&p};
    hipError_t e = hipLaunchCooperativeKernel((const void*)mega_fwd, dim3(grid), dim3(512), args, LDS_BYTES, stream);
    if (e != hipSuccess) fprintf(stderr, "cooperative launch failed: %s (grid %d)\n", hipGetErrorString(e), grid);
}
```

```cpp
#include <hip/hip_runtime.h>
#include <hip/hip_cooperative_groups.h>
#include <cstdio>
#include <cstdint>
namespace cg = cooperative_groups;
namespace pg8 {
#define PG8_LAS __attribute__((address_space(3)))
typedef unsigned short bf16_t;
typedef short bf16x8 __attribute__((ext_vector_type(8)));
typedef float f32x4 __attribute__((ext_vector_type(4)));
typedef unsigned u32x4 __attribute__((ext_vector_type(4)));
constexpr int BM = 256, BK = 64, HALF = 128, HTB = HALF * BK * 2  , STAGE_BYTES = 8 * HTB, NXCD = 8, WGM = 8;

__host__ __device__ __forceinline__ int lds_byte(int r, int c) { const int st = (r >> 4) * 2 + (c >> 5), rr = r & 15, cc = c & 31, ob = rr * 64 + cc * 2; return st * 1024 + (ob ^ (((ob >> 9) & 1) << 5)); }
__host__ __device__ __forceinline__ void stage_rc(int b, int& R, int& C) { const int st = b / 1024, sb = b % 1024, swz = sb ^ (((sb >> 9) & 1) << 5); R = (st >> 1) * 16 + swz / 64; C = (st & 1) * 32 + (swz % 64) / 2; }
__host__ __device__ __forceinline__ int perm32(int rho) { const int n = rho >> 4, i = rho & 15; return 8 * (i >> 2) + 4 * n + (i & 3); }

struct Unit { int pm, pn; };
struct Gemm { const bf16_t* A; const bf16_t* Bt; int M, N, K; };

struct StaticOrder {
    int nM, nN, nwg, G, c;
    __host__ __device__ void init(int M, int N, int G_, int c_) { nM = M / BM; nN = N / BM; nwg = nM * nN; G = G_; c = c_; }
    __host__ __device__ bool next(int i, Unit& u) const {
        const long L = (long)i * G + c; if (L >= nwg) return false;
        int wgid = (int)L; { const int q = nwg / NXCD, r = nwg % NXCD, xcd = wgid % NXCD, off = wgid / NXCD; wgid = (xcd < r ? xcd * (q + 1) : r * (q + 1) + (xcd - r) * q) + off; }
        const int nig = WGM * nN, gid = wgid / nig, fm = gid * WGM, gsz = (nM - fm) < WGM ? (nM - fm) : WGM;
        u.pm = fm + ((wgid % nig) % gsz); u.pn = (wgid % nig) / gsz; return true;
    }
    __device__ __forceinline__ void a_ready(const Unit&) const {}
    __device__ __forceinline__ void done(const Unit&) const {}
};
typedef float f32x2_cv __attribute__((ext_vector_type(2))); typedef __bf16 bf16x2_cv __attribute__((ext_vector_type(2)));
__device__ __forceinline__ unsigned cvt_pk_bf16(float lo, float hi) { f32x2_cv v = {lo, hi}; bf16x2_cv b = __builtin_convertvector(v, bf16x2_cv); return __builtin_bit_cast(unsigned, b); }
template <class Epi, class Sched, bool ALIGN_EPI = false, bool SP2 = false>
__device__ __forceinline__ void gemm_phase(PG8_LAS unsigned char* lds, const Gemm g, const Sched& S, const Epi& E) {
    int tid_ = threadIdx.x; asm volatile("" : "+v"(tid_));
    const int tid = tid_, wid = __builtin_amdgcn_readfirstlane(tid >> 6), lane = tid & 63, wr = wid >> 2, wc = wid & 3, fr = lane & 15, fq = lane >> 4;
    const int K = g.K, nt = K / BK;
    unsigned voffA[2], voffB[2];
#pragma unroll
    for (int i = 0; i < 2; ++i) { int R, C; stage_rc(tid * 16 + i * 8192, R, C); const int Rb = Epi::PERM ? ((R & ~31) + perm32(R & 31)) : R;
        voffA[i] = (unsigned)(R * K + C) * 2u; voffB[i] = (unsigned)(Rb * K + C) * 2u; }
    const size_t kstep = (size_t)(BK * 2);
    const size_t hstep = (size_t)HALF * K * 2;
    const size_t tstep = 2 * hstep;
    const unsigned ldsw = (unsigned)wid * 1024u; const unsigned ldsb0 = (unsigned)__builtin_amdgcn_readfirstlane((int)((unsigned)(uintptr_t)lds + ldsw));
    const int aoff = lds_byte(wr * 64 + fr, fq * 8), boff = lds_byte(wc * 32 + fr, fq * 8);
#define PG8_SA(b, h) (((b) * 2 + (h)) * HTB)
#define PG8_SB(b, h) ((4 + (b) * 2 + (h)) * HTB)
#define PG8_STAGE(bufoff, gbase, voff) do { _Pragma("unroll") for (int _i = 0; _i < 2; ++_i) \
        asm volatile("s_mov_b32 m0, %0\n\ts_nop 0\n\tglobal_load_lds_dwordx4 %1, %2" :: "s"(ldsb0 + (unsigned)((bufoff) + _i * 8192)), "v"((voff)[_i]), "s"((const char*)(gbase)) : "memory"); } while (0)
#define PG8_LDA(dst, b, h) do { _Pragma("unroll") for (int m = 0; m < 4; ++m) _Pragma("unroll") for (int k = 0; k < 2; ++k) dst[m][k] = *(const PG8_LAS bf16x8*)(lds + PG8_SA(b, h) + aoff + m * 2048 + k * 1024); } while (0)
#define PG8_LDB(dst, b, h) do { _Pragma("unroll") for (int n = 0; n < 2; ++n) _Pragma("unroll") for (int k = 0; k < 2; ++k) dst[n][k] = *(const PG8_LAS bf16x8*)(lds + PG8_SB(b, h) + boff + n * 2048 + k * 1024); } while (0)
#define PG8_MMA(ai, bj, At, Bt) do { __builtin_amdgcn_s_setprio(1); _Pragma("unroll") for (int m = 0; m < 4; ++m) _Pragma("unroll") for (int n = 0; n < 2; ++n) _Pragma("unroll") for (int k = 0; k < 2; ++k) \
        acc[ai][bj][m][n] = __builtin_amdgcn_mfma_f32_16x16x32_bf16(Bt[n][k], At[m][k], acc[ai][bj][m][n], 0, 0, 0); __builtin_amdgcn_s_setprio(0); } while (0)
#define PG8_WAIT_V(n) asm volatile("s_waitcnt vmcnt(" #n ")" ::: "memory")
#define PG8_WAIT_L(n) asm volatile("s_waitcnt lgkmcnt(" #n ")" ::: "memory")
#define PG8_BAR __builtin_amdgcn_s_barrier()
#define PG8_SCHED __builtin_amdgcn_sched_barrier(0)
    Unit cur, nxt; int ui = 0;
    if (!S.next(0, cur)) return;
    f32x4 acc[2][2][4][2];
#pragma unroll
    for (int a = 0; a < 2; ++a)
#pragma unroll
        for (int b = 0; b < 2; ++b)
#pragma unroll
            for (int m = 0; m < 4; ++m)
#pragma unroll
                for (int n = 0; n < 2; ++n) acc[a][b][m][n] = (f32x4){0.f, 0.f, 0.f, 0.f};
    bf16x8 At[4][2], B0[2][2], B1[2][2];
    const char* cA = (const char*)g.A + (size_t)cur.pm * tstep; const char* cB = (const char*)g.Bt + (size_t)cur.pn * tstep;
    S.a_ready(cur);
    if constexpr (SP2) {
        PG8_STAGE(PG8_SB(0, 0), cB, voffB); PG8_STAGE(PG8_SB(0, 1), cB + hstep, voffB); PG8_STAGE(PG8_SA(0, 0), cA, voffA); PG8_STAGE(PG8_SA(0, 1), cA + hstep, voffA);
        if (wr == 1) PG8_BAR;
        PG8_WAIT_V(2); PG8_BAR;
        PG8_STAGE(PG8_SB(1, 0), cB + kstep, voffB); PG8_STAGE(PG8_SA(1, 0), cA + kstep, voffA); PG8_STAGE(PG8_SB(1, 1), cB + hstep + kstep, voffB);
        PG8_WAIT_V(6); PG8_BAR;
    } else {
        PG8_STAGE(PG8_SB(0, 0), cB, voffB); PG8_STAGE(PG8_SA(0, 0), cA, voffA); PG8_STAGE(PG8_SB(0, 1), cB + hstep, voffB); PG8_STAGE(PG8_SA(0, 1), cA + hstep, voffA);
        if (wr == 1) PG8_BAR;
        PG8_WAIT_V(4); PG8_BAR;
        PG8_STAGE(PG8_SB(1, 0), cB + kstep, voffB); PG8_STAGE(PG8_SA(1, 0), cA + kstep, voffA); PG8_STAGE(PG8_SB(1, 1), cB + hstep + kstep, voffB);
        PG8_WAIT_V(6); PG8_BAR;
    }
    for (;;) {
        const bool has_next = S.next(ui + 1, nxt);
        const char* nA = has_next ? (const char*)g.A + (size_t)nxt.pm * tstep : cA; const char* nB = has_next ? (const char*)g.Bt + (size_t)nxt.pn * tstep : cB;
        for (int t = 0; t < nt; t += 2) {
            const bool last = (t == nt - 2);
            const char* a1 = cA + (size_t)(t + 1) * kstep;
            const char* a2 = last ? nA : cA + (size_t)(t + 2) * kstep; const char* b2 = last ? nB : cB + (size_t)(t + 2) * kstep;
            const char* a3 = a2 + kstep; const char* b3 = b2 + kstep;
            if (last && has_next) S.a_ready(nxt);
            if constexpr (SP2) {
            PG8_LDB(B0, 0, 0); PG8_LDB(B1, 0, 1); PG8_SCHED; PG8_LDA(At, 0, 0); PG8_STAGE(PG8_SA(1, 1), a1 + hstep, voffA);
            PG8_WAIT_V(8); PG8_WAIT_L(0); PG8_BAR; PG8_MMA(0, 0, At, B0); PG8_MMA(0, 1, At, B1); PG8_BAR; PG8_SCHED;
            PG8_LDA(At, 0, 1); PG8_STAGE(PG8_SB(0, 0), b2, voffB); PG8_STAGE(PG8_SB(0, 1), b2 + hstep, voffB); PG8_STAGE(PG8_SA(0, 0), a2, voffA);
            PG8_WAIT_V(8); PG8_WAIT_L(0); PG8_BAR; PG8_MMA(1, 0, At, B0); PG8_MMA(1, 1, At, B1); PG8_BAR; PG8_SCHED;
            PG8_LDB(B0, 1, 0); PG8_LDB(B1, 1, 1); PG8_SCHED; PG8_LDA(At, 1, 0); PG8_STAGE(PG8_SA(0, 1), a2 + hstep, voffA);
            PG8_WAIT_V(8); PG8_WAIT_L(0); PG8_BAR; PG8_MMA(0, 0, At, B0); PG8_MMA(0, 1, At, B1); PG8_BAR; PG8_SCHED;
            PG8_LDA(At, 1, 1); PG8_STAGE(PG8_SB(1, 0), b3, voffB); PG8_STAGE(PG8_SB(1, 1), b3 + hstep, voffB); PG8_STAGE(PG8_SA(1, 0), a3, voffA);
            PG8_WAIT_V(8); PG8_WAIT_L(0); PG8_BAR; PG8_MMA(1, 0, At, B0); PG8_MMA(1, 1, At, B1); PG8_BAR; PG8_SCHED;
            } else {
            PG8_LDB(B0, 0, 0); PG8_SCHED; PG8_LDA(At, 0, 0); PG8_STAGE(PG8_SA(1, 1), a1 + hstep, voffA);
            PG8_WAIT_L(8); PG8_BAR; PG8_WAIT_L(0); PG8_MMA(0, 0, At, B0); PG8_BAR; PG8_SCHED;
            PG8_LDB(B1, 0, 1); PG8_STAGE(PG8_SB(0, 0), b2, voffB);
            PG8_BAR; PG8_WAIT_L(0); PG8_MMA(0, 1, At, B1); PG8_BAR;
            PG8_LDA(At, 0, 1); PG8_STAGE(PG8_SA(0, 0), a2, voffA);
            PG8_BAR; PG8_WAIT_L(0); PG8_MMA(1, 0, At, B0); PG8_BAR; PG8_SCHED;
            PG8_STAGE(PG8_SB(0, 1), b2 + hstep, voffB);
            PG8_WAIT_V(6); PG8_BAR; PG8_MMA(1, 1, At, B1); PG8_BAR;
            PG8_LDB(B0, 1, 0); PG8_SCHED; PG8_LDA(At, 1, 0); PG8_STAGE(PG8_SA(0, 1), a2 + hstep, voffA);
            PG8_WAIT_L(8); PG8_BAR; PG8_WAIT_L(0); PG8_MMA(0, 0, At, B0); PG8_BAR; PG8_SCHED;
            PG8_LDB(B1, 1, 1); PG8_STAGE(PG8_SB(1, 0), b3, voffB);
            PG8_BAR; PG8_WAIT_L(0); PG8_MMA(0, 1, At, B1); PG8_BAR;
            PG8_LDA(At, 1, 1); PG8_STAGE(PG8_SA(1, 0), a3, voffA);
            PG8_BAR; PG8_WAIT_L(0); PG8_MMA(1, 0, At, B0); PG8_BAR; PG8_SCHED;
            PG8_STAGE(PG8_SB(1, 1), b3 + hstep, voffB);
            PG8_WAIT_V(6); PG8_BAR; PG8_MMA(1, 1, At, B1); PG8_BAR;
            }
        }
        if constexpr (ALIGN_EPI) { if (wr == 0) PG8_BAR; }
        if constexpr (!Epi::AFTER_DRAIN) { E(acc, cur, wr, wc, fr, fq); S.done(cur); }
        if (!has_next) break;
#pragma unroll
        for (int a = 0; a < 2; ++a)
#pragma unroll
            for (int b = 0; b < 2; ++b)
#pragma unroll
                for (int m = 0; m < 4; ++m)
#pragma unroll
                    for (int n = 0; n < 2; ++n) acc[a][b][m][n] = (f32x4){0.f, 0.f, 0.f, 0.f};
        cur = nxt; cA = nA; cB = nB; ++ui;
        if constexpr (ALIGN_EPI) { if (wr == 1) PG8_BAR; }
    }
    PG8_WAIT_V(0);
    if constexpr (!ALIGN_EPI) { if (wr == 0) PG8_BAR; }
    PG8_BAR;
    if constexpr (Epi::AFTER_DRAIN) { E.fused(acc, cur, wr, wc, fr, fq, lds, wid, lane); S.done(cur); }
#undef PG8_SA
#undef PG8_SB
#undef PG8_STAGE
#undef PG8_LDA
#undef PG8_LDB
#undef PG8_MMA
#undef PG8_WAIT_V
#undef PG8_WAIT_L
#undef PG8_BAR
#undef PG8_SCHED
}
}

#define LAS __attribute__((address_space(3)))
using pg8::bf16_t; using pg8::bf16x8; using pg8::f32x4; using pg8::u32x4; using pg8::Unit; using pg8::cvt_pk_bf16;
typedef float f32x16 __attribute__((ext_vector_type(16)));
typedef short v4i16_t __attribute__((ext_vector_type(4)));
typedef unsigned u32x2 __attribute__((ext_vector_type(2)));

constexpr int T = 81920, TP = 16384, SS = 2048, DM = 1024, FF = 2816, CH = 40960;
constexpr float EPS = 1e-6f, LOG2E = 1.4426950408889634f;
constexpr size_t MiB = 1u << 20;
constexpr size_t W_GU1 = 0, W_D1 = W_GU1 + 5632ull * 1024 * 2, W_GU2 = W_D1 + 1024ull * 2816 * 2, W_D2 = W_GU2 + 5632ull * 1024 * 2,
                 W_DIL = W_D2 + 1024ull * 2816 * 2, W_A = W_DIL + 4608ull * 1024 * 2, W_UQ = W_A + 1024ull * 1024 * 2, W_UKV = W_UQ + 2048ull * 512 * 2,
                 W_G = W_UKV + 2048ull * 256 * 2, W_OA = W_G + 2048ull * 1024 * 2, W_OB = W_OA + 1024ull * 1024 * 2, W_OUT = W_OB + 1024ull * 512 * 2,
                 W_PG = W_OUT + 1024ull * 1024 * 2, W_PE = W_PG + 1024ull * 1024 * 2, W_END = W_PE + 1024ull * 256 * 2;
static_assert(W_END <= 64 * MiB, "weights");
constexpr size_t S_BASE = 64 * MiB;
constexpr size_t S_RS0 = S_BASE, S_SSQ1 = S_RS0 + (size_t)T * 4, S_SSQ2 = S_SSQ1 + (size_t)T * 64, S_SSQ3 = S_SSQ2 + (size_t)T * 64,
                 S_SSQQ = S_SSQ3 + (size_t)T * 64, S_SSQKV = S_SSQQ + (size_t)T * 32, S_SSQPE = S_SSQKV + (size_t)T * 16, S_KPE = S_SSQPE + (size_t)T * 4,
                 S_L0 = S_KPE + (size_t)T * 256, S_L1 = S_L0 + (size_t)T * 32, S_MCOS = S_L1 + (size_t)T * 32, S_MSIN = S_MCOS + 16384ull * 32 * 4,
                 S_DCOS = S_MSIN + 16384ull * 32 * 4, S_DSIN = S_DCOS + 16384ull * 8 * 4, S_END = S_DSIN + 16384ull * 8 * 4;
constexpr size_t S_CTL = (S_END + 4095) / 4096 * 4096, CTL_BYTES = 16384;
static_assert(S_CTL + CTL_BYTES <= 128 * MiB, "small");
constexpr size_t XB_OFF = 128 * MiB;
constexpr size_t R = 288 * MiB;
constexpr size_t R_H = R, R_DIL = R, R_O0 = R + 240 * MiB, R_O1 = R + 320 * MiB, R_OD = R + 656 * MiB;
constexpr size_t R_Q = R, R_K = R + 120 * MiB, R_V = R + 240 * MiB, R_OM = R + 320 * MiB, R_CQ = R + 480 * MiB, R_CKV = R + 520 * MiB;
constexpr size_t R_GATES = R, R_TT = R + 480 * MiB, R_PB = R + 440 * MiB, R_PEO = R + 480 * MiB;
constexpr size_t WS_NEED = 1024 * MiB;

constexpr int LDS_BYTES = 147456, LDS_SCR = 131072;

struct Params { const float* in[28]; float* out; unsigned char* ws; };
typedef const __attribute__((address_space(4))) Params CParams;
__device__ __forceinline__ const void* uniform_ptr(const void* p) { const unsigned long long v = (unsigned long long)p; const unsigned lo = __builtin_amdgcn_readfirstlane((unsigned)v), hi = __builtin_amdgcn_readfirstlane((unsigned)(v >> 32)); return (const void*)(((unsigned long long)hi << 32) | lo); }

__device__ __forceinline__ int tok_pos(int row) { return row < TP ? row : (row & (SS - 1)); }
__device__ __forceinline__ float fsigmoid(float x) { return __builtin_amdgcn_rcpf(1.f + __builtin_amdgcn_exp2f(-x * LOG2E)); }
__device__ __forceinline__ float rs16(const float* ssq, int row) {
    const float a = __hip_atomic_load(ssq + row, __ATOMIC_RELAXED, __HIP_MEMORY_SCOPE_AGENT), b = __hip_atomic_load(ssq + T + row, __ATOMIC_RELAXED, __HIP_MEMORY_SCOPE_AGENT),
                c = __hip_atomic_load(ssq + 2 * T + row, __ATOMIC_RELAXED, __HIP_MEMORY_SCOPE_AGENT), d = __hip_atomic_load(ssq + 3 * T + row, __ATOMIC_RELAXED, __HIP_MEMORY_SCOPE_AGENT);
    return rsqrtf(((a + b) + (c + d)) * (1.f / 1024.f) + EPS);
}
__device__ __forceinline__ u32x4 pack8(f32x4 a, f32x4 b) { u32x4 w; w.x = cvt_pk_bf16(a[0], a[1]); w.y = cvt_pk_bf16(a[2], a[3]); w.z = cvt_pk_bf16(b[0], b[1]); w.w = cvt_pk_bf16(b[2], b[3]); return w; }
__device__ __forceinline__ float bf_lo(unsigned w) { return __builtin_bit_cast(float, w << 16); }
__device__ __forceinline__ float bf_hi(unsigned w) { return __builtin_bit_cast(float, w & 0xffff0000u); }
__device__ __forceinline__ float dot4(f32x4 v) { return (v[0] * v[0] + v[1] * v[1]) + (v[2] * v[2] + v[3] * v[3]); }
__device__ __forceinline__ float quad_sum(float s) { s += __shfl_xor(s, 16); s += __shfl_xor(s, 32); return s; }

#define EPI_ROWS(ai, m) (u.pm * 256 + (ai) * 128 + wr * 64 + (m) * 16 + fr)
typedef f32x4 (&AccRef)[2][2][4][2];

struct EpiSwiglu {
    static constexpr bool PERM = true, AFTER_DRAIN = false;
    const float* rs_direct; const float* ssq16; bf16_t* H;
    __device__ __forceinline__ void operator()(AccRef acc, const Unit& u, int wr, int wc, int fr, int fq) const {
        asm volatile("" : "+v"(fr), "+v"(fq));
#pragma unroll
        for (int ai = 0; ai < 2; ++ai)
#pragma unroll
            for (int m = 0; m < 4; ++m) { asm volatile("" ::: "memory");
                const int row = EPI_ROWS(ai, m); const float rs = rs_direct ? rs_direct[row] : rs16(ssq16, row);
                f32x4 h[2];
                const float nrl = -rs * LOG2E, rs2 = rs * rs;
#pragma unroll
                for (int n = 0; n < 2; ++n) { const f32x4 g = acc[ai][0][m][n], up = acc[ai][1][m][n];
#pragma unroll
                    for (int e = 0; e < 4; ++e) h[n][e] = (g[e] * up[e]) * (rs2 * __builtin_amdgcn_rcpf(1.f + __builtin_amdgcn_exp2f(g[e] * nrl))); }
                *(u32x4*)(H + (size_t)row * FF + u.pn * 128 + wc * 32 + fq * 8) = pack8(h[0], h[1]);
            }
    }
};
template <bool RESBF> struct EpiResid {
    static constexpr bool PERM = true, AFTER_DRAIN = false;
    const float* resA; const float* resB; bf16_t* xb; float* ssq; float scale; LAS float* scr;
    __device__ __forceinline__ void operator()(AccRef acc, const Unit& u, int wr, int wc, int fr, int fq) const {
        asm volatile("" : "+v"(fr), "+v"(fq));
#pragma unroll
        for (int ai = 0; ai < 2; ++ai)
#pragma unroll
            for (int m = 0; m < 4; ++m) { asm volatile("" ::: "memory");
                const int row = EPI_ROWS(ai, m); const float* rp = row < TP ? resA + (size_t)row * DM : resB + (size_t)(row - TP) * DM;
                float part = 0.f;
#pragma unroll
                for (int bj = 0; bj < 2; ++bj) { const int col0 = u.pn * 256 + bj * 128 + wc * 32 + fq * 8; f32x4 v[2];
                    if (RESBF) { const u32x4 p = *(const u32x4*)(xb + (size_t)row * DM + col0);
                        v[0] = (f32x4){bf_lo(p.x), bf_hi(p.x), bf_lo(p.y), bf_hi(p.y)} + acc[ai][bj][m][0] * scale; v[1] = (f32x4){bf_lo(p.z), bf_hi(p.z), bf_lo(p.w), bf_hi(p.w)} + acc[ai][bj][m][1] * scale;
                    } else {
#pragma unroll
                        for (int n = 0; n < 2; ++n) v[n] = *(const f32x4*)(rp + col0 + 4 * n) + acc[ai][bj][m][n] * scale; }
                    part += dot4(v[0]) + dot4(v[1]);
                    *(u32x4*)(xb + (size_t)row * DM + col0) = pack8(v[0], v[1]); }
                part = quad_sum(part);
                if (fq == 0) scr[(ai * 128 + wr * 64 + m * 16 + fr) * 4 + wc] = part;
            }
        asm volatile("s_waitcnt lgkmcnt(0)" ::: "memory"); __builtin_amdgcn_s_barrier(); asm volatile("" ::: "memory");
        if (wc == 0 && fq == 0) {
#pragma unroll
            for (int ai = 0; ai < 2; ++ai)
#pragma unroll
                for (int m = 0; m < 4; ++m) { const f32x4 pp = *(const LAS f32x4*)(scr + (ai * 128 + wr * 64 + m * 16 + fr) * 4);
                    ssq[(size_t)u.pn * T + EPI_ROWS(ai, m)] = (pp[0] + pp[1]) + (pp[2] + pp[3]); }
        }
    }
};
struct EpiDil {
    static constexpr bool PERM = true, AFTER_DRAIN = false;
    const float* ssq16; const float* gq; const float* gk; const float* dcos; const float* dsin; bf16_t* out;
    __device__ __forceinline__ void operator()(AccRef acc, const Unit& u, int wr, int wc, int fr, int fq) const {
        asm volatile("" : "+v"(fr), "+v"(fq));
        const int s = u.pn >> 1, h = (u.pn & 1) * 4 + wc;
        f32x4 g4[2][2];
        if (s < 2) { const float* gp = s == 0 ? gq : gk;
#pragma unroll
            for (int bj = 0; bj < 2; ++bj)
#pragma unroll
                for (int n = 0; n < 2; ++n) { const int d0 = (bj == 0 && fq < 2) ? 4 * fq + 8 * n : bj * 32 + 8 * fq + 4 * n; g4[bj][n] = *(const f32x4*)(gp + d0); } }
#pragma unroll
        for (int ai = 0; ai < 2; ++ai)
#pragma unroll
            for (int m = 0; m < 4; ++m) { asm volatile("" ::: "memory");
                const int row = EPI_ROWS(ai, m); const float rs = rs16(ssq16, row);
                f32x4 v[2][2]; float part = 0.f;
#pragma unroll
                for (int bj = 0; bj < 2; ++bj)
#pragma unroll
                    for (int n = 0; n < 2; ++n) { v[bj][n] = acc[ai][bj][m][n] * rs; part += dot4(v[bj][n]); }
                if (s < 2) {
                    part = quad_sum(part);
                    float rn = rsqrtf(part * (1.f / 64.f) + EPS); if (s == 0) rn *= 0.125f * LOG2E;
#pragma unroll
                    for (int bj = 0; bj < 2; ++bj)
#pragma unroll
                        for (int n = 0; n < 2; ++n) v[bj][n] = v[bj][n] * rn * g4[bj][n];
                    if (fq < 2) { const int pos = tok_pos(row); const f32x4 c = *(const f32x4*)(dcos + pos * 8 + 4 * fq), sn = *(const f32x4*)(dsin + pos * 8 + 4 * fq);
                        const f32x4 x1 = v[0][0], x2 = v[0][1]; v[0][0] = x1 * c - x2 * sn; v[0][1] = x2 * c + x1 * sn; }
                }
                bf16_t* o = out + (size_t)row * 1536 + s * 512 + h * 64 + fq * 8;
                *(u32x4*)(o) = pack8(v[0][0], v[0][1]); *(u32x4*)(o + 32) = pack8(v[1][0], v[1][1]);
            }
    }
};
struct EpiA {
    static constexpr bool PERM = true, AFTER_DRAIN = false;
    const float* ssq16; bf16_t* CQ; bf16_t* CKV; float* SSQQ; float* SSQKV; float* SSQPE; float* KPE; const float* gk; const float* mcos; const float* msin; int row0; LAS float* scr;
    __device__ __forceinline__ void operator()(AccRef acc, const Unit& u, int wr, int wc, int fr, int fq) const {
        asm volatile("" : "+v"(fr), "+v"(fq));
        const int pn = u.pn;
        if (!(pn == 3 && wc != 0)) {
#pragma unroll
        for (int ai = 0; ai < 2; ++ai)
#pragma unroll
            for (int m = 0; m < 4; ++m) { asm volatile("" ::: "memory");
                const int lrow = EPI_ROWS(ai, m), grow = row0 + lrow; const float rs = rs16(ssq16, grow);
                f32x4 v[2][2]; float part = 0.f;
#pragma unroll
                for (int bj = 0; bj < 2; ++bj)
#pragma unroll
                    for (int n = 0; n < 2; ++n) { v[bj][n] = acc[ai][bj][m][n] * rs; part += dot4(v[bj][n]); }
                part = quad_sum(part);
                if (pn < 2) {
                    bf16_t* o = CQ + (size_t)lrow * 512 + pn * 256 + wc * 32 + fq * 8;
                    *(u32x4*)o = pack8(v[0][0], v[0][1]); *(u32x4*)(o + 128) = pack8(v[1][0], v[1][1]);
                } else if (pn == 2) {
                    bf16_t* o = CKV + (size_t)lrow * 256 + wc * 32 + fq * 8;
                    *(u32x4*)o = pack8(v[0][0], v[0][1]); *(u32x4*)(o + 128) = pack8(v[1][0], v[1][1]);
                } else {
                    if (fq == 0) SSQPE[grow] = part;
                    const int pos = tok_pos(grow);
#pragma unroll
                    for (int n = 0; n < 2; ++n) { const int i0 = 8 * fq + 4 * n;
                        const f32x4 a = v[0][n] * *(const f32x4*)(gk + 128 + i0), b = v[1][n] * *(const f32x4*)(gk + 160 + i0);
                        const f32x4 c = *(const f32x4*)(mcos + pos * 32 + i0), sn = *(const f32x4*)(msin + pos * 32 + i0);
                        *(f32x4*)(KPE + (size_t)grow * 64 + i0) = a * c - b * sn; *(f32x4*)(KPE + (size_t)grow * 64 + 32 + i0) = b * c + a * sn; }
                }
                if (fq == 0) scr[(ai * 128 + wr * 64 + m * 16 + fr) * 4 + wc] = part;
            }
        }
        asm volatile("s_waitcnt lgkmcnt(0)" ::: "memory"); __builtin_amdgcn_s_barrier(); asm volatile("" ::: "memory");
        if (pn < 3 && wc == 0 && fq == 0) {
#pragma unroll
            for (int ai = 0; ai < 2; ++ai)
#pragma unroll
                for (int m = 0; m < 4; ++m) { const f32x4 pp = *(const LAS f32x4*)(scr + (ai * 128 + wr * 64 + m * 16 + fr) * 4); const float tot = (pp[0] + pp[1]) + (pp[2] + pp[3]);
                    const int grow = row0 + EPI_ROWS(ai, m);
                    if (pn < 2) SSQQ[(size_t)pn * T + grow] = tot; else SSQKV[grow] = tot; }
        }
    }
};
struct EpiQ {
    static constexpr bool PERM = true, AFTER_DRAIN = false;
    const float* SSQQ; const float* gq; const float* mcos; const float* msin; bf16_t* Q; LAS float* scr; int row0;
    __device__ __forceinline__ void operator()(AccRef acc, const Unit& u, int wr, int wc, int fr, int fq) const {
        asm volatile("" : "+v"(fr), "+v"(fq));
        const int h = u.pn;
#pragma unroll
        for (int ai = 0; ai < 2; ++ai)
#pragma unroll
            for (int m = 0; m < 4; ++m) { asm volatile("" ::: "memory");
                const int grow = row0 + EPI_ROWS(ai, m);
                const float rq = rsqrtf((SSQQ[grow] + SSQQ[T + grow]) * (1.f / 512.f) + EPS);
                float part = 0.f;
#pragma unroll
                for (int bj = 0; bj < 2; ++bj)
#pragma unroll
                    for (int n = 0; n < 2; ++n) { acc[ai][bj][m][n] = acc[ai][bj][m][n] * rq; part += dot4(acc[ai][bj][m][n]); }
                part = quad_sum(part);
                if (fq == 0) scr[(ai * 128 + wr * 64 + m * 16 + fr) * 4 + wc] = part;
            }
        asm volatile("s_waitcnt lgkmcnt(0)" ::: "memory"); __builtin_amdgcn_s_barrier(); asm volatile("" ::: "memory");
        if (wc == 3) return;
        f32x4 g4[2][2];
#pragma unroll
        for (int bj = 0; bj < 2; ++bj)
#pragma unroll
            for (int n = 0; n < 2; ++n) g4[bj][n] = *(const f32x4*)(gq + wc * 64 + bj * 32 + 8 * fq + 4 * n);
#pragma unroll
        for (int ai = 0; ai < 2; ++ai)
#pragma unroll
            for (int m = 0; m < 4; ++m) { asm volatile("" ::: "memory");
                const int lrow = EPI_ROWS(ai, m), grow = row0 + lrow;
                const f32x4 pp = *(const LAS f32x4*)(scr + (ai * 128 + wr * 64 + m * 16 + fr) * 4);
                const float rn = rsqrtf(((pp[0] + pp[1]) + pp[2]) * (1.f / 192.f) + EPS) * (0.07216878364870322f * LOG2E);
                f32x4 v[2][2];
#pragma unroll
                for (int bj = 0; bj < 2; ++bj)
#pragma unroll
                    for (int n = 0; n < 2; ++n) v[bj][n] = acc[ai][bj][m][n] * rn * g4[bj][n];
                if (wc == 2) { const int pos = tok_pos(grow);
#pragma unroll
                    for (int n = 0; n < 2; ++n) { const int i0 = 8 * fq + 4 * n; const f32x4 c = *(const f32x4*)(mcos + pos * 32 + i0), sn = *(const f32x4*)(msin + pos * 32 + i0);
                        const f32x4 a = v[0][n], b = v[1][n]; v[0][n] = a * c - b * sn; v[1][n] = b * c + a * sn; } }
                bf16_t* o = Q + (size_t)lrow * 1536 + h * 192 + wc * 64 + fq * 8;
                *(u32x4*)o = pack8(v[0][0], v[0][1]); *(u32x4*)(o + 32) = pack8(v[1][0], v[1][1]);
            }
    }
};
struct EpiKV {
    static constexpr bool PERM = true, AFTER_DRAIN = false;
    const float* SSQKV; const float* SSQPE; const float* KPE; const float* gk; bf16_t* K; bf16_t* V; LAS float* scr; int row0;
    __device__ __forceinline__ void operator()(AccRef acc, const Unit& u, int wr, int wc, int fr, int fq) const {
        asm volatile("" : "+v"(fr), "+v"(fq));
        const int h = u.pn;
#pragma unroll
        for (int ai = 0; ai < 2; ++ai)
#pragma unroll
            for (int m = 0; m < 4; ++m) { asm volatile("" ::: "memory");
                const int grow = row0 + EPI_ROWS(ai, m);
                const float rkv = rsqrtf(SSQKV[grow] * (1.f / 256.f) + EPS);
                float part = 0.f;
#pragma unroll
                for (int bj = 0; bj < 2; ++bj)
#pragma unroll
                    for (int n = 0; n < 2; ++n) { acc[ai][bj][m][n] = acc[ai][bj][m][n] * rkv; part += dot4(acc[ai][bj][m][n]); }
                part = quad_sum(part);
                if (fq == 0 && wc < 2) scr[(ai * 128 + wr * 64 + m * 16 + fr) * 2 + wc] = part;
            }
        asm volatile("s_waitcnt lgkmcnt(0)" ::: "memory"); __builtin_amdgcn_s_barrier(); asm volatile("" ::: "memory");
        float rn[2][4];
#pragma unroll
        for (int ai = 0; ai < 2; ++ai)
#pragma unroll
            for (int m = 0; m < 4; ++m) { const int grow = row0 + EPI_ROWS(ai, m); const int rl = ai * 128 + wr * 64 + m * 16 + fr;
                rn[ai][m] = rsqrtf((scr[rl * 2] + scr[rl * 2 + 1] + SSQPE[grow]) * (1.f / 192.f) + EPS); }
        if (wc < 2) {
#pragma unroll
            for (int bj = 0; bj < 2; ++bj) {
                const f32x4 g0 = *(const f32x4*)(gk + wc * 64 + bj * 32 + 8 * fq), g1 = *(const f32x4*)(gk + wc * 64 + bj * 32 + 8 * fq + 4);
#pragma unroll
                for (int ai = 0; ai < 2; ++ai)
#pragma unroll
                    for (int m = 0; m < 4; ++m) { const int lrow = EPI_ROWS(ai, m);
                        *(u32x4*)(K + (size_t)lrow * 1536 + h * 192 + wc * 64 + bj * 32 + fq * 8) = pack8(acc[ai][bj][m][0] * rn[ai][m] * g0, acc[ai][bj][m][1] * rn[ai][m] * g1); }
                asm volatile("" ::: "memory");
            }
        } else {
#pragma unroll
            for (int ai = 0; ai < 2; ++ai)
#pragma unroll
                for (int m = 0; m < 4; ++m) { asm volatile("" ::: "memory");
                    const int lrow = EPI_ROWS(ai, m), grow = row0 + lrow;
                    bf16_t* o = V + (size_t)lrow * 1024 + h * 128 + (wc - 2) * 64 + fq * 8;
                    *(u32x4*)o = pack8(acc[ai][0][m][0], acc[ai][0][m][1]); *(u32x4*)(o + 32) = pack8(acc[ai][1][m][0], acc[ai][1][m][1]);
                    const int j0 = (wc - 2) * 32 + fq * 8; const f32x4 k0 = *(const f32x4*)(KPE + (size_t)grow * 64 + j0), k1 = *(const f32x4*)(KPE + (size_t)grow * 64 + j0 + 4);
                    *(u32x4*)(K + (size_t)lrow * 1536 + h * 192 + 128 + j0) = pack8(k0 * rn[ai][m], k1 * rn[ai][m]); }
        }
    }
};
template <int MODE> struct EpiEW {
    static constexpr bool PERM = true, AFTER_DRAIN = false;
    const float* ssq16; const bf16_t* aux; int ldaux; bf16_t* out; int ldo;
    __device__ __forceinline__ void operator()(AccRef acc, const Unit& u, int wr, int wc, int fr, int fq) const {
        asm volatile("" : "+v"(fr), "+v"(fq));
#pragma unroll
        for (int ai = 0; ai < 2; ++ai)
#pragma unroll
            for (int m = 0; m < 4; ++m) { asm volatile("" ::: "memory");
                const int row = EPI_ROWS(ai, m); float rs = 1.f; if (MODE == 0 || MODE == 5) rs = rs16(ssq16, row);
#pragma unroll
                for (int bj = 0; bj < 2; ++bj) { const int col0 = u.pn * 256 + bj * 128 + wc * 32 + fq * 8; f32x4 v[2] = {acc[ai][bj][m][0], acc[ai][bj][m][1]};
                    if (MODE == 0 || MODE == 4) {
#pragma unroll
                        for (int n = 0; n < 2; ++n)
#pragma unroll
                            for (int e = 0; e < 4; ++e) v[n][e] = __builtin_amdgcn_rcpf(1.f + __builtin_amdgcn_exp2f(v[n][e] * (-rs * LOG2E)));
                    } else if (MODE == 5) { v[0] = v[0] * rs; v[1] = v[1] * rs;
                    } else if (MODE == 1 || MODE == 2) {
                        const u32x4 g = *(const u32x4*)(aux + (size_t)row * ldaux + col0);
                        const f32x4 ga = {bf_lo(g.x), bf_hi(g.x), bf_lo(g.y), bf_hi(g.y)}, gb = {bf_lo(g.z), bf_hi(g.z), bf_lo(g.w), bf_hi(g.w)};
                        v[0] = v[0] * ga; v[1] = v[1] * gb;
                        if (MODE == 2) { const u32x4 p = *(const u32x4*)(out + (size_t)row * ldo + col0);
                            v[0] = v[0] + (f32x4){bf_lo(p.x), bf_hi(p.x), bf_lo(p.y), bf_hi(p.y)}; v[1] = v[1] + (f32x4){bf_lo(p.z), bf_hi(p.z), bf_lo(p.w), bf_hi(p.w)}; }
                    }
                    *(u32x4*)(out + (size_t)row * ldo + col0) = pack8(v[0], v[1]); }
            }
    }
};
struct EpiFinal {
    static constexpr bool PERM = true, AFTER_DRAIN = false;
    const float* ssq16; const bf16_t* pe; const bf16_t* xb; float* out;
    __device__ __forceinline__ void operator()(AccRef acc, const Unit& u, int wr, int wc, int fr, int fq) const {
        asm volatile("" : "+v"(fr), "+v"(fq));
#pragma unroll
        for (int ai = 0; ai < 2; ++ai)
#pragma unroll
            for (int m = 0; m < 4; ++m) { asm volatile("" ::: "memory");
                const int row = EPI_ROWS(ai, m); const float rs = rs16(ssq16, row);
#pragma unroll
                for (int bj = 0; bj < 2; ++bj) { const int col0 = u.pn * 256 + bj * 128 + wc * 32 + fq * 8;
                    const u32x4 g = *(const u32x4*)(pe + (size_t)row * DM + col0), p = *(const u32x4*)(xb + (size_t)row * DM + col0);
                    const f32x4 pa = {bf_lo(g.x), bf_hi(g.x), bf_lo(g.y), bf_hi(g.y)}, pb = {bf_lo(g.z), bf_hi(g.z), bf_lo(g.w), bf_hi(g.w)};
                    f32x4 x0 = {bf_lo(p.x), bf_hi(p.x), bf_lo(p.y), bf_hi(p.y)}, x1 = {bf_lo(p.z), bf_hi(p.z), bf_lo(p.w), bf_hi(p.w)};
                    float* o = out + (size_t)row * DM + col0;
#pragma unroll
                    for (int e = 0; e < 4; ++e) { x0[e] += __builtin_amdgcn_rcpf(1.f + __builtin_amdgcn_exp2f(acc[ai][bj][m][0][e] * (-rs * LOG2E))) * pa[e]; x1[e] += __builtin_amdgcn_rcpf(1.f + __builtin_amdgcn_exp2f(acc[ai][bj][m][1][e] * (-rs * LOG2E))) * pb[e]; }
                    *(f32x4*)o = x0; *(f32x4*)(o + 4) = x1; }
            }
    }
};

template <class E> __device__ __forceinline__ void run_gemm(LAS unsigned char* lds, const bf16_t* A, const bf16_t* Bt, int M, int N, int K, const E& e) {
    asm volatile("" : "+s"(K));
    A = (const bf16_t*)uniform_ptr(A); Bt = (const bf16_t*)uniform_ptr(Bt);
    pg8::Gemm g{A, Bt, M, N, K}; pg8::StaticOrder S; S.init(M, N, (int)gridDim.x, (int)blockIdx.x);
    pg8::gemm_phase<E, pg8::StaticOrder, true, true>(lds, g, S, e);
}

struct WDesc { const float* src; const float* src2; const float* gain; bf16_t* dst; int K, Nsrc, Ndst, map; };
__device__ __forceinline__ int wcolmap(int map, int n, int& which) {
    which = 0;
    const int tp = n & 255, bj = tp >> 7, wc = (tp >> 5) & 3, c = tp & 31;
    switch (map) {
    case 0: return n;
    case 1: which = bj; return (n >> 8) * 128 + (tp & 127);
    case 2: { const int g = n / 1536, nn = n - g * 1536, pn = nn >> 8, s = pn >> 1, hh = pn & 1, h = hh * 4 + wc, p = bj * 32 + c;
              const int d = (s < 2 && p < 16) ? (4 * (p >> 3) + 8 * ((p >> 2) & 1) + (p & 3)) : p; return 832 + g * 1536 + s * 512 + h * 64 + d; }
    case 3: { if (n < 768) return n; const int t = n - 768; if (t < 32) return 768 + t; if (t >= 128 && t < 160) return 800 + (t - 128); return -1; }
    case 4: { if (wc == 3) return -1; return (n >> 8) * 192 + wc * 64 + bj * 32 + c; }
    case 5: { const int h = n >> 8; return wc < 2 ? h * 256 + wc * 64 + bj * 32 + c : h * 256 + 128 + (wc - 2) * 64 + bj * 32 + c; }
    case 6: return 5440 + n;
    }
    return -1;
}
__device__ __forceinline__ void transpose_item(const WDesc& d, LAS float* scr, int item, int lane) {
    const int nblk = d.Ndst / 32, kb = item / nblk, nb = item - kb * nblk, k0 = 64 * kb, n0 = 32 * nb;
    int which; const int col = wcolmap(d.map, n0 + (lane & 31), which); const bool up = (d.map == 1) && (((n0 >> 7) & 1) != 0); const float* src = (const float*)uniform_ptr(up ? d.src2 : d.src);
    float tv[32];
#pragma unroll
    for (int i = 0; i < 32; ++i) { const int kk = 2 * i + (lane >> 5); float v = 0.f; if (col >= 0) { v = src[(size_t)(k0 + kk) * d.Nsrc + col]; } tv[i] = v; }
#pragma unroll
    for (int i = 0; i < 32; ++i) { const int kk = 2 * i + (lane >> 5); float v = tv[i]; if (d.gain) v *= d.gain[k0 + kk]; scr[kk * 33 + (lane & 31)] = v; }
    asm volatile("s_waitcnt lgkmcnt(0)" ::: "memory");
    const int c = lane & 7;
#pragma unroll
    for (int j = 0; j < 4; ++j) { const int n = (lane >> 3) + 8 * j; const LAS float* s = scr + (8 * c) * 33 + n;
        u32x4 o; o.x = cvt_pk_bf16(s[0 * 33], s[1 * 33]); o.y = cvt_pk_bf16(s[2 * 33], s[3 * 33]); o.z = cvt_pk_bf16(s[4 * 33], s[5 * 33]); o.w = cvt_pk_bf16(s[6 * 33], s[7 * 33]);
        *(u32x4*)(d.dst + (size_t)(n0 + n) * d.K + k0 + 8 * c) = o; }
    asm volatile("s_waitcnt lgkmcnt(0)" ::: "memory");
}
__device__ __forceinline__ float wave_sum(float v) {
#pragma unroll
    for (int o = 1; o < 64; o <<= 1) v += __shfl_xor(v, o);
    return v;
}
__device__ __forceinline__ void prologue(CParams& P, LAS unsigned char* lds) {
    int tid_ = threadIdx.x; asm volatile("" : "+v"(tid_));
    const int tid = tid_, lane = tid & 63, wave = tid >> 6; const int gw = blockIdx.x * 8 + wave, NGW = gridDim.x * 8;
    LAS float* scr = (LAS float*)(lds + wave * 16384);
    int base = 0; unsigned char* ws = P.ws;
#define WCONV(SRC, SRC2, GAIN, DSTOFF, KK, NSRC, NDST, MAP) { const WDesc d{SRC, SRC2, GAIN, (bf16_t*)(ws + (DSTOFF)), KK, NSRC, NDST, MAP}; constexpr int items = ((KK) / 64) * ((NDST) / 32); \
        for (int it = (gw - base % NGW + NGW) % NGW; it < items; it += NGW) transpose_item(d, scr, it, lane); base += items; asm volatile("" ::: "memory"); }
    WCONV(P.in[5], P.in[6], P.in[4], W_GU1, 1024, 2816, 5632, 1)
    WCONV(P.in[7], nullptr, nullptr, W_D1, 2816, 1024, 1024, 0)
    WCONV(P.in[22], P.in[23], P.in[21], W_GU2, 1024, 2816, 5632, 1)
    WCONV(P.in[24], nullptr, nullptr, W_D2, 2816, 1024, 1024, 0)
    WCONV(P.in[9], nullptr, P.in[8], W_DIL, 1024, 7488, 4608, 2)
    WCONV(P.in[9], nullptr, P.in[8], W_A, 1024, 7488, 1024, 3)
    WCONV(P.in[11], nullptr, P.in[10], W_UQ, 512, 1536, 2048, 4)
    WCONV(P.in[13], nullptr, P.in[12], W_UKV, 256, 2048, 2048, 5)
    WCONV(P.in[9], nullptr, P.in[8], W_G, 1024, 7488, 2048, 6)
    WCONV(P.in[18], nullptr, nullptr, W_OA, 1024, 1024, 1024, 0)
    WCONV(P.in[19], nullptr, nullptr, W_OB, 512, 1024, 1024, 0)
    WCONV(P.in[20], nullptr, nullptr, W_OUT, 1024, 1024, 1024, 0)
    WCONV(P.in[27], nullptr, P.in[25], W_PG, 1024, 1024, 1024, 0)
    WCONV(P.in[26], nullptr, nullptr, W_PE, 256, 1024, 1024, 0)
#undef WCONV
    bf16_t* XB = (bf16_t*)(P.ws + XB_OFF); float* RS0 = (float*)(P.ws + S_RS0);
    for (int m = gw; m < T; m += NGW) { const float* xr = m < TP ? P.in[0] + (size_t)m * DM : P.in[1] + (size_t)(m - TP) * DM;
        f32x4 v[4]; float s = 0.f;
#pragma unroll
        for (int j = 0; j < 4; ++j) { v[j] = ((const f32x4*)xr)[lane + 64 * j]; s += dot4(v[j]); }
        s = wave_sum(s);
#pragma unroll
        for (int j = 0; j < 4; ++j) { u32x2 w; w.x = cvt_pk_bf16(v[j][0], v[j][1]); w.y = cvt_pk_bf16(v[j][2], v[j][3]); ((u32x2*)(XB + (size_t)m * DM))[lane + 64 * j] = w; }
        if (lane == 0) RS0[m] = rsqrtf(s * (1.f / 1024.f) + EPS); }
    float* mcos = (float*)(P.ws + S_MCOS); float* msin = (float*)(P.ws + S_MSIN); float* dcos = (float*)(P.ws + S_DCOS); float* dsin = (float*)(P.ws + S_DSIN);
    const int gt = blockIdx.x * 512 + tid, NT = gridDim.x * 512;
    for (int i = gt; i < 16384 * 40; i += NT) { const bool big = i < 16384 * 32; const int j = big ? i : i - 16384 * 32; const int pos = big ? (j >> 5) : (j >> 3), f = big ? (j & 31) : (j & 7);
        const double inv = exp2(-18.931568569324174 * (double)f / (big ? 32.0 : 8.0)); double xr = (double)pos * inv * 0.15915494309189535; xr -= floor(xr); const float rev = (float)xr;
        const float cs = __builtin_amdgcn_cosf(rev), sn = __builtin_amdgcn_sinf(rev);
        if (big) { mcos[j] = cs; msin[j] = sn; } else { dcos[j] = cs; dsin[j] = sn; } }
}

__device__ __forceinline__ bf16x8 vtr8(const LAS unsigned char* lo, const LAS unsigned char* hi) {
    const v4i16_t a = __builtin_amdgcn_ds_read_tr16_b64_v4i16((LAS v4i16_t*)lo), b = __builtin_amdgcn_ds_read_tr16_b64_v4i16((LAS v4i16_t*)hi);
    return (bf16x8){a[0], a[1], a[2], a[3], b[0], b[1], b[2], b[3]};
}
constexpr int MLA_KP = 400, MLA_KB = 64 * MLA_KP, MLA_VB = 16384, MLA_VOFF = 3 * MLA_KB;
__device__ __forceinline__ void mla_unit(LAS unsigned char* lds, const bf16_t* Qg, const bf16_t* Kg, const bf16_t* Vg, bf16_t* Og, int qrow0, int krow0, int nkt, int h, size_t orow0) {
    int tid_ = threadIdx.x; asm volatile("" : "+v"(tid_));
    const int tid = tid_, lane = tid & 63, wave = tid >> 6, l31 = lane & 31, hi = lane >> 5;
    bf16x8 qf[12];
    { const bf16_t* qp = Qg + (size_t)(qrow0 + wave * 32 + l31) * 1536 + h * 192 + hi * 8;
#pragma unroll
      for (int ks = 0; ks < 12; ++ks) qf[ks] = *(const bf16x8*)(qp + ks * 16); }
    const int skey = tid >> 3, sc8 = tid & 7;
    const bf16_t* kbase = Kg + (size_t)(krow0 + skey) * 1536 + h * 192 + sc8 * 8; const bf16_t* vbase = Vg + (size_t)(krow0 + skey) * 1024 + h * 128 + sc8 * 8;
    const int klds = skey * MLA_KP + sc8 * 16, vlds = MLA_VOFF + ((skey >> 3) * 4 + (sc8 >> 2)) * 512 + (skey & 7) * 64 + (sc8 & 3) * 16;
    u32x4 kr[3], vr[2];
#define MLA_LOADK(t) do { _Pragma("unroll") for (int i = 0; i < 3; ++i) kr[i] = *(const u32x4*)(kbase + (size_t)(t) * (64 * 1536) + i * 64); } while (0)
#define MLA_LOADV(t) do { _Pragma("unroll") for (int i = 0; i < 2; ++i) vr[i] = *(const u32x4*)(vbase + (size_t)(t) * (64 * 1024) + i * 64); } while (0)
#define MLA_STOREK(off) do { _Pragma("unroll") for (int i = 0; i < 3; ++i) *(LAS u32x4*)(lds + (off) + klds + i * 128) = kr[i]; } while (0)
#define MLA_STOREV(off) do { _Pragma("unroll") for (int i = 0; i < 2; ++i) *(LAS u32x4*)(lds + (off) + vlds + i * 1024) = vr[i]; } while (0)
    f32x16 O[4];
#pragma unroll
    for (int dt = 0; dt < 4; ++dt)
#pragma unroll
        for (int r = 0; r < 16; ++r) O[dt][r] = 0.f;
    float mrun = -INFINITY, lrun = 0.f;
    const int koff = l31 * MLA_KP + hi * 16;
    const int voff = MLA_VOFF + (4 * hi + ((lane & 15) >> 2)) * 64 + (((lane >> 4) & 1) * 16 + (lane & 3) * 4) * 2;
    f32x16 sa0, sa1, sb0, sb1; bf16x8 pf[4];
#define MLA_QK(S0, S1, KOFF) do { const LAS unsigned char* sb_ = lds + (KOFF); \
        _Pragma("unroll") for (int r = 0; r < 16; ++r) { S0[r] = 0.f; S1[r] = 0.f; } \
        bf16x8 kq[2][2]; \
        kq[0][0] = *(const LAS bf16x8*)(sb_ + koff); kq[0][1] = *(const LAS bf16x8*)(sb_ + koff + 32 * MLA_KP); \
        _Pragma("unroll") for (int ks = 0; ks < 12; ++ks) { \
            if (ks < 11) { kq[(ks + 1) & 1][0] = *(const LAS bf16x8*)(sb_ + koff + (ks + 1) * 32); kq[(ks + 1) & 1][1] = *(const LAS bf16x8*)(sb_ + koff + 32 * MLA_KP + (ks + 1) * 32); } \
            S0 = __builtin_amdgcn_mfma_f32_32x32x16_bf16(kq[ks & 1][0], qf[ks], S0, 0, 0, 0); S1 = __builtin_amdgcn_mfma_f32_32x32x16_bf16(kq[ks & 1][1], qf[ks], S1, 0, 0, 0); } } while (0)
#define MLA_SM(S0, S1) do { float mx = fmaxf(S0[0], S1[0]); \
        _Pragma("unroll") for (int r = 1; r < 16; ++r) mx = fmaxf(mx, fmaxf(S0[r], S1[r])); \
        { const auto rr_ = __builtin_amdgcn_permlane32_swap(__float_as_uint(mx), __float_as_uint(mx), false, false); mx = fmaxf(__uint_as_float(rr_[0]), __uint_as_float(rr_[1])); } \
        if (__any(mx > mrun + 6.0f)) { const float mnew = fmaxf(mrun, mx), alpha = __builtin_amdgcn_exp2f(mrun - mnew); mrun = mnew; lrun *= alpha; \
            _Pragma("unroll") for (int dt = 0; dt < 4; ++dt) _Pragma("unroll") for (int r = 0; r < 16; ++r) O[dt][r] *= alpha; } \
        float ls = 0.f; \
        _Pragma("unroll") for (int r = 0; r < 16; ++r) { S0[r] = __builtin_amdgcn_exp2f(S0[r] - mrun); S1[r] = __builtin_amdgcn_exp2f(S1[r] - mrun); ls += S0[r] + S1[r]; } \
        lrun += ls; \
        _Pragma("unroll") for (int j = 0; j < 2; ++j) { u32x4 w0, w1; \
            w0.x = cvt_pk_bf16(S0[8 * j + 0], S0[8 * j + 1]); w0.y = cvt_pk_bf16(S0[8 * j + 2], S0[8 * j + 3]); w0.z = cvt_pk_bf16(S0[8 * j + 4], S0[8 * j + 5]); w0.w = cvt_pk_bf16(S0[8 * j + 6], S0[8 * j + 7]); \
            w1.x = cvt_pk_bf16(S1[8 * j + 0], S1[8 * j + 1]); w1.y = cvt_pk_bf16(S1[8 * j + 2], S1[8 * j + 3]); w1.z = cvt_pk_bf16(S1[8 * j + 4], S1[8 * j + 5]); w1.w = cvt_pk_bf16(S1[8 * j + 6], S1[8 * j + 7]); \
            pf[j] = __builtin_bit_cast(bf16x8, w0); pf[2 + j] = __builtin_bit_cast(bf16x8, w1); } } while (0)
#define MLA_PV(VOFFB) do { const LAS unsigned char* sb_ = lds + (VOFFB); bf16x8 vq[2][2]; \
        vq[0][0] = vtr8(sb_ + voff, sb_ + voff + 4 * 512); vq[0][1] = vtr8(sb_ + voff + 512, sb_ + voff + 5 * 512); \
        _Pragma("unroll") for (int st = 0; st < 8; ++st) { const int kg = st >> 1, dp = st & 1; \
            if (st < 7) { const int kg2 = (st + 1) >> 1, dp2 = (st + 1) & 1; \
                vq[(st + 1) & 1][0] = vtr8(sb_ + voff + ((2 * kg2) * 4 + 2 * dp2) * 512, sb_ + voff + ((2 * kg2 + 1) * 4 + 2 * dp2) * 512); \
                vq[(st + 1) & 1][1] = vtr8(sb_ + voff + ((2 * kg2) * 4 + 2 * dp2 + 1) * 512, sb_ + voff + ((2 * kg2 + 1) * 4 + 2 * dp2 + 1) * 512); } \
            O[2 * dp] = __builtin_amdgcn_mfma_f32_32x32x16_bf16(vq[st & 1][0], pf[kg], O[2 * dp], 0, 0, 0); \
            O[2 * dp + 1] = __builtin_amdgcn_mfma_f32_32x32x16_bf16(vq[st & 1][1], pf[kg], O[2 * dp + 1], 0, 0, 0); } } while (0)
#define MLA_STEP(t, SC0, SC1, SN0, SN1) do { const bool more1 = ((t) + 1 < nkt), more2 = ((t) + 2 < nkt); \
        if (more1) { MLA_QK(SN0, SN1, k_nxt); } \
        if (more2) MLA_LOADK((t) + 2); \
        MLA_SM(SC0, SC1); \
        if (more1) MLA_LOADV((t) + 1); \
        MLA_PV(((t) & 1) * MLA_VB); \
        if (more2) MLA_STOREK(k_prv); \
        if (more1) MLA_STOREV((((t) + 1) & 1) * MLA_VB); \
        __syncthreads(); \
        { const int tmp_ = k_prv; k_prv = k_cur; k_cur = k_nxt; k_nxt = tmp_; } } while (0)
    { u32x4 k1r[3];
      MLA_LOADK(0); MLA_LOADV(0);
#pragma unroll
      for (int i = 0; i < 3; ++i) k1r[i] = *(const u32x4*)(kbase + (size_t)(64 * 1536) + i * 64);
      MLA_STOREK(0); MLA_STOREV(0);
#pragma unroll
      for (int i = 0; i < 3; ++i) *(LAS u32x4*)(lds + MLA_KB + klds + i * 128) = k1r[i]; }
    __syncthreads();
    int k_cur = 0, k_nxt = MLA_KB, k_prv = 2 * MLA_KB;
    MLA_QK(sa0, sa1, k_cur);
    for (int t = 0; t < nkt; t += 2) {
        MLA_STEP(t, sa0, sa1, sb0, sb1);
        MLA_STEP(t + 1, sb0, sb1, sa0, sa1);
    }
    lrun += __shfl_xor(lrun, 32);
    const float inv = 1.f / lrun;
    bf16_t* op = Og + (orow0 + wave * 32 + l31) * 1024 + h * 128 + 4 * hi;
#pragma unroll
    for (int dt = 0; dt < 4; ++dt)
#pragma unroll
        for (int a = 0; a < 4; ++a) { u32x2 w; w.x = cvt_pk_bf16(O[dt][4 * a] * inv, O[dt][4 * a + 1] * inv); w.y = cvt_pk_bf16(O[dt][4 * a + 2] * inv, O[dt][4 * a + 3] * inv);
            *(u32x2*)(op + dt * 32 + a * 8) = w; }
#undef MLA_LOADK
#undef MLA_LOADV
#undef MLA_STOREK
#undef MLA_STOREV
#undef MLA_QK
#undef MLA_SM
#undef MLA_PV
#undef MLA_STEP
}
__device__ __forceinline__ void mla_phase(LAS unsigned char* lds, CParams& P, int chunk) {
    const bf16_t* Qg = (const bf16_t*)(P.ws + R_Q); const bf16_t* Kg = (const bf16_t*)(P.ws + R_K); const bf16_t* Vg = (const bf16_t*)(P.ws + R_V); bf16_t* Og = (bf16_t*)(P.ws + R_OM);
    const int G = gridDim.x, nbig = chunk == 0 ? 512 : 0, ntot = 1280;
    for (int idx = blockIdx.x; idx < ntot; idx += G) {
        int h, qrow0, krow0, nkt;
        if (idx < nbig) { h = idx & 7; krow0 = 0; qrow0 = (idx >> 3) * 256; nkt = 256; }
        else { const int s = idx - nbig; h = s & 7; const int qb = (s >> 3) & 7, seq = s >> 6; krow0 = (chunk == 0 ? TP : 0) + seq * SS; qrow0 = krow0 + qb * 256; nkt = 32; }
        mla_unit(lds, Qg, Kg, Vg, Og, qrow0, krow0, nkt, h, (size_t)chunk * CH + qrow0);
    }
}

__device__ __forceinline__ void dil_phase(LAS unsigned char* lds, CParams& P, int g) {
    const bf16_t* DIL = (const bf16_t*)(P.ws + R_DIL);
    const int sh = 2 * g, dmask = (1 << sh) - 1;
    int tid_ = threadIdx.x; asm volatile("" : "+v"(tid_));
    const int tid = tid_, lane = tid & 63, wave = tid >> 6, hb = wave >> 2, w = wave & 3, tl = tid & 255, l31 = lane & 31, hi = lane >> 5;
    LAS unsigned char* vb = lds + hb * 32768;
    const int voff = (4 * hi + ((lane & 15) >> 2)) * 64 + (((lane >> 4) & 1) * 16 + (lane & 3) * 4) * 2;
    u32x4 vr[8];
#define DIL_VLOAD(BU) do { const int su_ = 2 * (BU) + hb; int t0_, S_, loc_; \
        if (su_ < 1024) { t0_ = 0; S_ = TP; loc_ = su_; } else { const int s_ = (su_ - 1024) >> 7; t0_ = TP + s_ * SS; S_ = SS; loc_ = (su_ - 1024) & 127; } \
        const int h_ = loc_ & 7, rest_ = loc_ >> 3, r_ = rest_ & dmask, qb_ = rest_ >> sh, L_ = S_ >> sh, subb_ = 128 * qb_ - 64; \
        _Pragma("unroll") for (int i = 0; i < 8; ++i) { const int c = tl + 256 * i, key = c >> 3, ch = c & 7; int sub = subb_ + key; sub = sub < 0 ? 0 : (sub > L_ - 1 ? L_ - 1 : sub); \
            vr[i] = *(const u32x4*)(DIL + (size_t)(t0_ + (sub << sh) + r_) * 1536 + 1024 + h_ * 64 + ch * 8); } } while (0)
    if ((int)blockIdx.x < 2560) DIL_VLOAD((int)blockIdx.x);
    for (int bu = blockIdx.x; bu < 2560; bu += gridDim.x) {
        const int su = 2 * bu + hb; int t0, S, loc;
        if (su < 1024) { t0 = 0; S = TP; loc = su; } else { const int s = (su - 1024) >> 7; t0 = TP + s * SS; S = SS; loc = (su - 1024) & 127; }
        const int h = loc & 7, rest = loc >> 3, r = rest & dmask, qb = rest >> sh, L = S >> sh, sub_b = 128 * qb - 64;
#pragma unroll
        for (int i = 0; i < 8; ++i) { const int c = tl + 256 * i, key = c >> 3, ch = c & 7; *(LAS u32x4*)(vb + ((key >> 3) * 2 + (ch >> 2)) * 512 + (key & 7) * 64 + (ch & 3) * 16) = vr[i]; }
        asm volatile("" ::: "memory");
        const int qsub = 128 * qb + 32 * w + l31; const size_t tokq = (size_t)(t0 + (qsub << sh) + r);
        bf16x8 qf[4];
#pragma unroll
        for (int ks = 0; ks < 4; ++ks) qf[ks] = *(const bf16x8*)(DIL + tokq * 1536 + h * 64 + ks * 16 + hi * 8);
        f32x16 sc[5];
        bf16x8 kfr[5][4];
#pragma unroll
        for (int kt = 0; kt < 5; ++kt) { int sub = sub_b + 32 * w + 32 * kt + l31; sub = sub < 0 ? 0 : (sub > L - 1 ? L - 1 : sub);
            const bf16_t* kp = DIL + (size_t)(t0 + (sub << sh) + r) * 1536 + 512 + h * 64 + hi * 8;
#pragma unroll
            for (int ks = 0; ks < 4; ++ks) kfr[kt][ks] = *(const bf16x8*)(kp + ks * 16); }
        if (bu + (int)gridDim.x < 2560) DIL_VLOAD(bu + (int)gridDim.x);
#pragma unroll
        for (int kt = 0; kt < 5; ++kt) {
#pragma unroll
            for (int r2 = 0; r2 < 16; ++r2) sc[kt][r2] = 0.f;
#pragma unroll
            for (int ks = 0; ks < 4; ++ks) sc[kt] = __builtin_amdgcn_mfma_f32_32x32x16_bf16(kfr[kt][ks], qf[ks], sc[kt], 0, 0, 0);
        }
        float mx = -INFINITY;
#pragma unroll
        for (int kt = 0; kt < 5; ++kt)
#pragma unroll
            for (int r2 = 0; r2 < 16; ++r2) { const int keyl = (r2 & 3) + 8 * (r2 >> 2) + 4 * hi; const int rel = -64 + 32 * kt + keyl - l31; const int ksub = sub_b + 32 * w + 32 * kt + keyl;
                const bool ok = (rel >= -64) && (rel <= 64) && (ksub >= 0) && (ksub < L); sc[kt][r2] = ok ? sc[kt][r2] : -INFINITY; mx = fmaxf(mx, sc[kt][r2]); }
        { const auto rr_ = __builtin_amdgcn_permlane32_swap(__float_as_uint(mx), __float_as_uint(mx), false, false); mx = fmaxf(__uint_as_float(rr_[0]), __uint_as_float(rr_[1])); }
        float ls = 0.f;
#pragma unroll
        for (int kt = 0; kt < 5; ++kt)
#pragma unroll
            for (int r2 = 0; r2 < 16; ++r2) { sc[kt][r2] = __builtin_amdgcn_exp2f(sc[kt][r2] - mx); ls += sc[kt][r2]; }
        { const auto rr_ = __builtin_amdgcn_permlane32_swap(__float_as_uint(ls), __float_as_uint(ls), false, false); ls = __uint_as_float(rr_[0]) + __uint_as_float(rr_[1]); }
        __syncthreads();
        f32x16 O[2];
#pragma unroll
        for (int dt = 0; dt < 2; ++dt)
#pragma unroll
            for (int r2 = 0; r2 < 16; ++r2) O[dt][r2] = 0.f;
#pragma unroll
        for (int kt = 0; kt < 5; ++kt)
#pragma unroll
            for (int j = 0; j < 2; ++j) {
                u32x4 pw; pw.x = cvt_pk_bf16(sc[kt][8 * j + 0], sc[kt][8 * j + 1]); pw.y = cvt_pk_bf16(sc[kt][8 * j + 2], sc[kt][8 * j + 3]); pw.z = cvt_pk_bf16(sc[kt][8 * j + 4], sc[kt][8 * j + 5]); pw.w = cvt_pk_bf16(sc[kt][8 * j + 6], sc[kt][8 * j + 7]);
                const bf16x8 pf = __builtin_bit_cast(bf16x8, pw); const int kg = 2 * w + 2 * kt + j;
#pragma unroll
                for (int dt = 0; dt < 2; ++dt) { const bf16x8 vf = vtr8(vb + voff + ((2 * kg) * 2 + dt) * 512, vb + voff + ((2 * kg + 1) * 2 + dt) * 512);
                    O[dt] = __builtin_amdgcn_mfma_f32_32x32x16_bf16(vf, pf, O[dt], 0, 0, 0); }
            }
        const float inv = 1.f / ls, lse = mx + __builtin_amdgcn_logf(ls);
        if (g < 2) { bf16_t* Og = (bf16_t*)(P.ws + (g == 0 ? R_O0 : R_O1)); float* Lg = (float*)(P.ws + (g == 0 ? S_L0 : S_L1));
#pragma unroll
            for (int dt = 0; dt < 2; ++dt)
#pragma unroll
                for (int a = 0; a < 4; ++a) { u32x2 wv; wv.x = cvt_pk_bf16(O[dt][4 * a] * inv, O[dt][4 * a + 1] * inv); wv.y = cvt_pk_bf16(O[dt][4 * a + 2] * inv, O[dt][4 * a + 3] * inv);
                    *(u32x2*)(Og + tokq * 512 + h * 64 + dt * 32 + a * 8 + 4 * hi) = wv; }
            if (hi == 0) Lg[(size_t)h * T + t0 + r * L + qsub] = lse;
        } else { bf16_t* Og = (bf16_t*)(P.ws + R_OD); const bf16_t* O0 = (const bf16_t*)(P.ws + R_O0); const bf16_t* O1 = (const bf16_t*)(P.ws + R_O1); const float* L0 = (const float*)(P.ws + S_L0); const float* L1 = (const float*)(P.ws + S_L1);
            const int pos = (qsub << sh) + r; const float l0 = L0[(size_t)h * T + t0 + pos], l1 = L1[(size_t)h * T + t0 + (pos & 3) * (S >> 2) + (pos >> 2)]; const float mm = fmaxf(fmaxf(l0, l1), lse);
            float w0 = __builtin_amdgcn_exp2f(l0 - mm), w1 = __builtin_amdgcn_exp2f(l1 - mm), w2 = __builtin_amdgcn_exp2f(lse - mm); const float wi = 1.f / (w0 + w1 + w2);
            w0 *= wi; w1 *= wi; w2 *= wi * inv;
#pragma unroll
            for (int dt = 0; dt < 2; ++dt)
#pragma unroll
                for (int a = 0; a < 4; ++a) { const size_t off = tokq * 512 + h * 64 + dt * 32 + a * 8 + 4 * hi; const u32x2 a0 = *(const u32x2*)(O0 + off), a1 = *(const u32x2*)(O1 + off);
                    const float o0 = w0 * bf_lo(a0.x) + w1 * bf_lo(a1.x) + w2 * O[dt][4 * a], o1 = w0 * bf_hi(a0.x) + w1 * bf_hi(a1.x) + w2 * O[dt][4 * a + 1],
                                o2 = w0 * bf_lo(a0.y) + w1 * bf_lo(a1.y) + w2 * O[dt][4 * a + 2], o3 = w0 * bf_hi(a0.y) + w1 * bf_hi(a1.y) + w2 * O[dt][4 * a + 3];
                    u32x2 wv; wv.x = cvt_pk_bf16(o0, o1); wv.y = cvt_pk_bf16(o2, o3); *(u32x2*)(Og + off) = wv; }
        }
        __syncthreads();
    }
}


#define XB_TMO      128
#define XB_XCNT(j)  (256  + 64 * (j))
#define XB_XSUB(j)  (1280 + 64 * (j))
#define XB_XGEN(j)  (2304 + 64 * (j))
#define XB_TOP      3328
#define XB_TOPGEN   3392
#define XCD_BAR_WORDS 3456
#define XB_SPIN_CAP (1u << 28)

__device__ __forceinline__ unsigned xb_ld(unsigned* p)              { return __hip_atomic_load(p, __ATOMIC_RELAXED, __HIP_MEMORY_SCOPE_AGENT); }
__device__ __forceinline__ unsigned xb_add(unsigned* p, unsigned v) { return __hip_atomic_fetch_add(p, v, __ATOMIC_RELAXED, __HIP_MEMORY_SCOPE_AGENT); }
__device__ __forceinline__ unsigned xb_xcc_id() { return (unsigned)__builtin_amdgcn_s_getreg((3 << 11) | 20) & 0xFu; }
#define XB_SPIN(cond, bar) do { unsigned _sp = 0; while (cond) { __builtin_amdgcn_s_sleep(1); \
    if ((++_sp & 255u) == 0u) { if (xb_ld(&(bar)[XB_TMO])) break; if (_sp > XB_SPIN_CAP) { atomicAdd(&(bar)[XB_TMO], 1u); break; } } } } while (0)

struct XcdBarrier {
    unsigned* bar; unsigned x;
    volatile LAS unsigned* st;
};

__device__ __forceinline__ XcdBarrier xcd_barrier_post(unsigned* bar, volatile LAS unsigned* st) {
    XcdBarrier b; b.bar = bar; b.x = xb_xcc_id(); b.st = st;
    if (threadIdx.x == 0) (void)xb_add(&bar[XB_XCNT(b.x)], 1u);
    return b;
}
__device__ __forceinline__ void xcd_barrier_complete(unsigned* bar, unsigned x, unsigned& nloc, unsigned& nx) {
    const unsigned G = gridDim.x * gridDim.y * gridDim.z;
    unsigned sum, cnt, mine, sp = 0u;
    for (;;) {
        sum = 0u; cnt = 0u; mine = 0u;
#pragma unroll
        for (unsigned j = 0; j < 16; ++j) { const unsigned c = xb_ld(&bar[XB_XCNT(j)]); sum += c; cnt += (c > 0u) ? 1u : 0u; mine = (j == x) ? c : mine; }
        if (sum == G) break;
        __builtin_amdgcn_s_sleep(1);
        if ((++sp & 255u) == 0u) { if (xb_ld(&bar[XB_TMO])) break; if (sp > XB_SPIN_CAP) { atomicAdd(&bar[XB_TMO], 1u); break; } }
    }
    nloc = mine > 0u ? mine : 1u; nx = cnt > 0u ? cnt : 1u;
}

__device__ __forceinline__ void xcd_barrier(const XcdBarrier& b) {
    asm volatile("s_waitcnt vmcnt(0)" ::: "memory");
    __syncthreads();
    if (threadIdx.x == 0) {
        unsigned* bar = b.bar;
        __builtin_amdgcn_s_waitcnt(0);
        unsigned nloc = b.st[0], nx = b.st[1];
        if (nloc == 0u) { xcd_barrier_complete(bar, b.x, nloc, nx); b.st[0] = nloc; b.st[1] = nx; }
        const unsigned old = xb_add(&bar[XB_XSUB(b.x)], 1u);
        const unsigned gen = old / nloc;
        if (old + 1u == (gen + 1u) * nloc) {
            __builtin_amdgcn_fence(__ATOMIC_RELEASE, "agent");
            asm volatile("s_waitcnt vmcnt(0)" ::: "memory");
            const unsigned og = xb_add(&bar[XB_TOP], 1u);
            const unsigned tg = og / nx;
            if (og + 1u == (tg + 1u) * nx) xb_add(&bar[XB_TOPGEN], 1u);
            else XB_SPIN(xb_ld(&bar[XB_TOPGEN]) == tg, bar);
            __builtin_amdgcn_fence(__ATOMIC_ACQUIRE, "");
            xb_add(&bar[XB_XGEN(b.x)], 1u);
            asm volatile("s_waitcnt vmcnt(0)" ::: "memory");
        } else {
            XB_SPIN(xb_ld(&bar[XB_XGEN(b.x)]) == gen, bar);
            __builtin_amdgcn_fence(__ATOMIC_ACQUIRE, "agent");
            asm volatile("s_waitcnt vmcnt(0)" ::: "memory");
        }
    }
    __syncthreads();
}


__device__ __forceinline__ void dbg_dump(float* out, const bf16_t* src, int ncols) {
    const size_t n = (size_t)T * ncols; const size_t gt = (size_t)blockIdx.x * 512 + threadIdx.x, NT = (size_t)gridDim.x * 512;
    for (size_t i = gt; i < n; i += NT) { const size_t row = i / ncols, c = i - row * ncols; out[row * DM + c] = bf_lo((unsigned)src[i]); }
}
#ifndef DBG_STOP
#define DBG_STOP 0
#endif
#undef DIL_VLOAD
#define FRESH() CParams& P = *pp; unsigned char* ws = P.ws; bf16_t* XB = (bf16_t*)(ws + XB_OFF); bf16_t* H = (bf16_t*)(ws + R_H); (void)XB; (void)H; \
    float* SSQ1 = (float*)(ws + S_SSQ1); float* SSQ2 = (float*)(ws + S_SSQ2); float* SSQ3 = (float*)(ws + S_SSQ3); (void)SSQ1; (void)SSQ2; (void)SSQ3; \
    const float* mcos = (const float*)(ws + S_MCOS); const float* msin = (const float*)(ws + S_MSIN); const float* dcos = (const float*)(ws + S_DCOS); const float* dsin = (const float*)(ws + S_DSIN); (void)mcos; (void)msin; (void)dcos; (void)dsin;
#define GSYNC() do { XcdBarrier xb_; xb_.bar = (unsigned*)(pp->ws + S_CTL); xb_.x = xb_xcc_id(); xb_.st = (volatile LAS unsigned*)(lds + LDS_SCR + 8192); xcd_barrier(xb_); asm volatile("" : "+s"(pp) :: "memory"); } while (0)
__global__ void __launch_bounds__(512) mega_fwd(Params Pbyval) {
    extern __shared__ __attribute__((aligned(16))) unsigned char lds_raw[];
    LAS unsigned char* lds = (LAS unsigned char*)lds_raw;
    LAS float* scr = (LAS float*)(lds + LDS_SCR);
    cg::grid_group grid = cg::this_grid();
    CParams* pp = (CParams*)__builtin_amdgcn_kernarg_segment_ptr();
    asm volatile("" : "+s"(pp) :: "memory");
    volatile LAS unsigned* xst = (volatile LAS unsigned*)(lds + LDS_SCR + 8192);
    if (threadIdx.x < 2) xst[threadIdx.x] = 0u;
    __syncthreads();
    (void)xcd_barrier_post((unsigned*)(pp->ws + S_CTL), xst);
    grid.sync();

    { FRESH(); prologue(P, lds); }
#ifdef PROBE_PROL2
    GSYNC();
    { FRESH(); prologue(P, lds); }
#endif
    GSYNC();
    { FRESH(); EpiSwiglu e{(const float*)(ws + S_RS0), nullptr, H}; run_gemm(lds, XB, (const bf16_t*)(ws + W_GU1), T, 5632, 1024, e); }
#ifdef PROBE_G1X2
    GSYNC();
    { FRESH(); EpiSwiglu e{(const float*)(ws + S_RS0), nullptr, H}; run_gemm(lds, XB, (const bf16_t*)(ws + W_GU1), T, 5632, 1024, e); }
#endif
    GSYNC();
    { FRESH(); EpiResid<false> e{P.in[0], P.in[1], XB, SSQ1, 0.5f, scr}; run_gemm(lds, H, (const bf16_t*)(ws + W_D1), T, 1024, FF, e); }
    GSYNC();
    if (DBG_STOP == 1) return;
    if (DBG_STOP == 11) { { FRESH(); EpiDil e{SSQ1, P.in[16], P.in[17], dcos, dsin, (bf16_t*)(ws + R_DIL)}; run_gemm(lds, XB, (const bf16_t*)(ws + W_DIL), T, 1536, 1024, e); }
        GSYNC();
        { FRESH(); const size_t gt = (size_t)blockIdx.x * 512 + threadIdx.x, NT = (size_t)gridDim.x * 512; const bf16_t* G = (const bf16_t*)(ws + R_DIL);
          for (size_t i = gt; i < (size_t)T * 1024; i += NT) { const size_t row = i >> 10, c = i & 1023; P.out[i] = bf_lo((unsigned)G[row * 1536 + c]) + bf_lo((unsigned)G[row * 1536 + 512 + c]); } } return; }
    for (int g = 0; g < ((DBG_STOP == 9 || DBG_STOP == 12) ? 0 : 3); ++g) {
        { FRESH(); EpiDil e{SSQ1, P.in[16] + g * 64, P.in[17] + g * 64, dcos, dsin, (bf16_t*)(ws + R_DIL)}; run_gemm(lds, XB, (const bf16_t*)(ws + W_DIL) + (size_t)g * 1536 * 1024, T, 1536, 1024, e); }
        GSYNC();
        { FRESH(); dil_phase(lds, P, g); }
#ifdef PROBE_DIL2
        GSYNC();
        { FRESH(); dil_phase(lds, P, g); }
#endif
        GSYNC();
    }
    if (DBG_STOP == 2) { FRESH(); dbg_dump(P.out, (const bf16_t*)(ws + R_OD), 512); return; }
    for (int c = 0; c < ((DBG_STOP == 9 || DBG_STOP == 12) ? 0 : 2); ++c) {
        const int row0 = c * CH;
        { FRESH(); EpiA e{SSQ1, (bf16_t*)(ws + R_CQ), (bf16_t*)(ws + R_CKV), (float*)(ws + S_SSQQ), (float*)(ws + S_SSQKV), (float*)(ws + S_SSQPE), (float*)(ws + S_KPE), P.in[15], mcos, msin, row0, scr};
          run_gemm(lds, XB + (size_t)row0 * DM, (const bf16_t*)(ws + W_A), CH, 1024, 1024, e); }
        GSYNC();
        { FRESH(); EpiQ e{(const float*)(ws + S_SSQQ), P.in[14], mcos, msin, (bf16_t*)(ws + R_Q), scr, row0}; run_gemm(lds, (const bf16_t*)(ws + R_CQ), (const bf16_t*)(ws + W_UQ), CH, 2048, 512, e); }
        { FRESH(); EpiKV e{(const float*)(ws + S_SSQKV), (const float*)(ws + S_SSQPE), (const float*)(ws + S_KPE), P.in[15], (bf16_t*)(ws + R_K), (bf16_t*)(ws + R_V), scr, row0};
          run_gemm(lds, (const bf16_t*)(ws + R_CKV), (const bf16_t*)(ws + W_UKV), CH, 2048, 256, e); }
        GSYNC();
        { FRESH(); mla_phase(lds, P, c); }
#ifdef PROBE_MLA2
        GSYNC();
        { FRESH(); mla_phase(lds, P, c); }
#endif
        GSYNC();
    }
    if (DBG_STOP == 3) { FRESH(); dbg_dump(P.out, (const bf16_t*)(ws + R_OM), 1024); return; }
#ifdef PROBE_BAR10
    for (int i = 0; i < 10; ++i) GSYNC();
#endif
    if (DBG_STOP == 12) { FRESH(); EpiEW<5> e{SSQ1, nullptr, 0, (bf16_t*)(ws + R_GATES), 2048}; run_gemm(lds, XB, (const bf16_t*)(ws + W_G), T, 2048, 1024, e); } else
    { FRESH(); EpiEW<0> e{SSQ1, nullptr, 0, (bf16_t*)(ws + R_GATES), 2048}; run_gemm(lds, XB, (const bf16_t*)(ws + W_G), T, 2048, 1024, e); }
#ifdef PROBE_P9X2
    GSYNC();
    { FRESH(); EpiEW<0> e{SSQ1, nullptr, 0, (bf16_t*)(ws + R_GATES), 2048}; run_gemm(lds, XB, (const bf16_t*)(ws + W_G), T, 2048, 1024, e); }
#endif
    GSYNC();
    if (DBG_STOP == 8 || DBG_STOP == 9 || DBG_STOP == 12) { FRESH(); const size_t gt = (size_t)blockIdx.x * 512 + threadIdx.x, NT = (size_t)gridDim.x * 512; const bf16_t* G = (const bf16_t*)(ws + R_GATES);
        for (size_t i = gt; i < (size_t)T * 1024; i += NT) { const size_t row = i >> 10, c = i & 1023; P.out[i] = bf_lo((unsigned)G[row * 2048 + c]) + bf_lo((unsigned)G[row * 2048 + 1024 + c]); } return; }
    { FRESH(); EpiEW<1> e{nullptr, (const bf16_t*)(ws + R_GATES), 2048, (bf16_t*)(ws + R_TT), 1024}; run_gemm(lds, (const bf16_t*)(ws + R_OM), (const bf16_t*)(ws + W_OA), T, 1024, 1024, e); }
    GSYNC();
    if (DBG_STOP == 6) { FRESH(); dbg_dump(P.out, (const bf16_t*)(ws + R_TT), 1024); return; }
    { FRESH(); EpiEW<2> e{nullptr, (const bf16_t*)(ws + R_GATES) + 1024, 2048, (bf16_t*)(ws + R_TT), 1024}; run_gemm(lds, (const bf16_t*)(ws + R_OD), (const bf16_t*)(ws + W_OB), T, 1024, 512, e); }
    GSYNC();
    if (DBG_STOP == 7) { FRESH(); dbg_dump(P.out, (const bf16_t*)(ws + R_TT), 1024); return; }
    { FRESH(); EpiResid<true> e{nullptr, nullptr, XB, SSQ2, 1.0f, scr}; run_gemm(lds, (const bf16_t*)(ws + R_TT), (const bf16_t*)(ws + W_OUT), T, 1024, 1024, e); }
    GSYNC();
    if (DBG_STOP == 4) return;
    { FRESH(); bf16_t* PB = (bf16_t*)(ws + R_PB); const int gt = blockIdx.x * 512 + threadIdx.x, NT = gridDim.x * 512;
      for (int i = gt; i < T * 64; i += NT) { const int row = i >> 6, c4 = i & 63; const float* pr = row < TP ? P.in[2] + (size_t)row * 256 : P.in[3] + (size_t)(row - TP) * 256;
          const f32x4 v = ((const f32x4*)pr)[c4]; u32x2 w; w.x = cvt_pk_bf16(v[0], v[1]); w.y = cvt_pk_bf16(v[2], v[3]); ((u32x2*)(PB + (size_t)row * 256))[c4] = w; } }
    { FRESH(); EpiSwiglu e{nullptr, SSQ2, H}; run_gemm(lds, XB, (const bf16_t*)(ws + W_GU2), T, 5632, 1024, e); }
    GSYNC();
    { FRESH(); EpiResid<true> e{nullptr, nullptr, XB, SSQ3, 0.5f, scr}; run_gemm(lds, H, (const bf16_t*)(ws + W_D2), T, 1024, FF, e); }
    { FRESH(); EpiEW<3> e{nullptr, nullptr, 0, (bf16_t*)(ws + R_PEO), 1024}; run_gemm(lds, (const bf16_t*)(ws + R_PB), (const bf16_t*)(ws + W_PE), T, 1024, 256, e); }
    GSYNC();
    if (DBG_STOP == 5) return;
    { FRESH(); EpiFinal e{SSQ3, (const bf16_t*)(ws + R_PEO), XB, P.out}; run_gemm(lds, XB, (const bf16_t*)(ws + W_PG), T, 1024, 1024, e); }
}

extern "C" void kernel_launch(void* const* d_in, const int* in_sizes, int n_in, void* d_out, int out_size, void* d_ws, size_t ws_size, hipStream_t stream) {
    static int grid = 0;
    if (grid == 0) {
        if (n_in != 28 || out_size != T * DM || ws_size < WS_NEED) { fprintf(stderr, "kernel_launch: unexpected shapes (n_in %d out %d ws %zu)\n", n_in, out_size, ws_size); grid = -1; return; }
        int dev = 0, cus = 0, per_cu = 0;
        hipGetDevice(&dev); hipDeviceGetAttribute(&cus, hipDeviceAttributeMultiprocessorCount, dev);
        hipFuncSetAttribute((const void*)mega_fwd, hipFuncAttributeMaxDynamicSharedMemorySize, LDS_BYTES);
        hipOccupancyMaxActiveBlocksPerMultiprocessor(&per_cu, (const void*)mega_fwd, 512, LDS_BYTES);
        if (per_cu < 1) per_cu = 1;
        grid = cus * 1;
        (void)hipGetLastError();
    }
    if (grid < 0) return;
    Params p{};
    for (int i = 0; i < 28; ++i) p.in[i] = (const float*)d_in[i];
    p.out = (float*)d_out; p.ws = (unsigned char*)d_ws;
    hipMemsetAsync((char*)d_ws + S_CTL, 0, CTL_BYTES, stream);
    void* args[] = {&p};
    hipError_t e = hipLaunchCooperativeKernel((const void*)mega_fwd, dim3(grid), dim3(512), args, LDS_BYTES, stream);
    if (e != hipSuccess) fprintf(stderr, "cooperative launch failed: %s (grid %d)\n", hipGetErrorString(e), grid);
}
```

```cpp
#include <hip/hip_runtime.h>
#include <hip/hip_cooperative_groups.h>
#include <cstdio>
#include <cstdint>
namespace cg = cooperative_groups;
namespace pg8 {
#define PG8_LAS __attribute__((address_space(3)))
typedef unsigned short bf16_t;
typedef short bf16x8 __attribute__((ext_vector_type(8)));
typedef float f32x4 __attribute__((ext_vector_type(4)));
typedef unsigned u32x4 __attribute__((ext_vector_type(4)));
constexpr int BM = 256, BK = 64, HALF = 128, HTB = HALF * BK * 2  , STAGE_BYTES = 8 * HTB, NXCD = 8, WGM = 8;

__host__ __device__ __forceinline__ int lds_byte(int r, int c) { const int st = (r >> 4) * 2 + (c >> 5), rr = r & 15, cc = c & 31, ob = rr * 64 + cc * 2; return st * 1024 + (ob ^ (((ob >> 9) & 1) << 5)); }
__host__ __device__ __forceinline__ void stage_rc(int b, int& R, int& C) { const int st = b / 1024, sb = b % 1024, swz = sb ^ (((sb >> 9) & 1) << 5); R = (st >> 1) * 16 + swz / 64; C = (st & 1) * 32 + (swz % 64) / 2; }
__host__ __device__ __forceinline__ int perm32(int rho) { const int n = rho >> 4, i = rho & 15; return 8 * (i >> 2) + 4 * n + (i & 3); }

struct Unit { int pm, pn; };
struct Gemm { const bf16_t* A; const bf16_t* Bt; int M, N, K; };

struct StaticOrder {
    int nM, nN, nwg, G, c;
    __host__ __device__ void init(int M, int N, int G_, int c_) { nM = M / BM; nN = N / BM; nwg = nM * nN; G = G_; c = c_; }
    __host__ __device__ bool next(int i, Unit& u) const {
        const long L = (long)i * G + c; if (L >= nwg) return false;
        int wgid = (int)L; { const int q = nwg / NXCD, r = nwg % NXCD, xcd = wgid % NXCD, off = wgid / NXCD; wgid = (xcd < r ? xcd * (q + 1) : r * (q + 1) + (xcd - r) * q) + off; }
        const int nig = WGM * nN, gid = wgid / nig, fm = gid * WGM, gsz = (nM - fm) < WGM ? (nM - fm) : WGM;
        u.pm = fm + ((wgid % nig) % gsz); u.pn = (wgid % nig) / gsz; return true;
    }
    __device__ __forceinline__ void a_ready(const Unit&) const {}
    __device__ __forceinline__ void done(const Unit&) const {}
};
typedef float f32x2_cv __attribute__((ext_vector_type(2))); typedef __bf16 bf16x2_cv __attribute__((ext_vector_type(2)));
__device__ __forceinline__ unsigned cvt_pk_bf16(float lo, float hi) { f32x2_cv v = {lo, hi}; bf16x2_cv b = __builtin_convertvector(v, bf16x2_cv); return __builtin_bit_cast(unsigned, b); }
template <class Epi, class Sched, bool ALIGN_EPI = false, bool SP2 = false>
__device__ __forceinline__ void gemm_phase(PG8_LAS unsigned char* lds, const Gemm g, const Sched& S, const Epi& E) {
    int tid_ = threadIdx.x; asm volatile("" : "+v"(tid_));
    const int tid = tid_, wid = __builtin_amdgcn_readfirstlane(tid >> 6), lane = tid & 63, wr = wid >> 2, wc = wid & 3, fr = lane & 15, fq = lane >> 4;
    const int K = g.K, nt = K / BK;
    unsigned voffA[2], voffB[2];
#pragma unroll
    for (int i = 0; i < 2; ++i) { int R, C; stage_rc(tid * 16 + i * 8192, R, C); const int Rb = Epi::PERM ? ((R & ~31) + perm32(R & 31)) : R;
        voffA[i] = (unsigned)(R * K + C) * 2u; voffB[i] = (unsigned)(Rb * K + C) * 2u; }
    const size_t kstep = (size_t)(BK * 2);
    const size_t hstep = (size_t)HALF * K * 2;
    const size_t tstep = 2 * hstep;
    const unsigned ldsw = (unsigned)wid * 1024u; const unsigned ldsb0 = (unsigned)__builtin_amdgcn_readfirstlane((int)((unsigned)(uintptr_t)lds + ldsw));
    const int aoff = lds_byte(wr * 64 + fr, fq * 8), boff = lds_byte(wc * 32 + fr, fq * 8);
#define PG8_SA(b, h) (((b) * 2 + (h)) * HTB)
#define PG8_SB(b, h) ((4 + (b) * 2 + (h)) * HTB)
#define PG8_STAGE(bufoff, gbase, voff) do { _Pragma("unroll") for (int _i = 0; _i < 2; ++_i) \
        asm volatile("s_mov_b32 m0, %0\n\ts_nop 0\n\tglobal_load_lds_dwordx4 %1, %2" :: "s"(ldsb0 + (unsigned)((bufoff) + _i * 8192)), "v"((voff)[_i]), "s"((const char*)(gbase)) : "memory"); } while (0)
#define PG8_LDA(dst, b, h) do { _Pragma("unroll") for (int m = 0; m < 4; ++m) _Pragma("unroll") for (int k = 0; k < 2; ++k) dst[m][k] = *(const PG8_LAS bf16x8*)(lds + PG8_SA(b, h) + aoff + m * 2048 + k * 1024); } while (0)
#define PG8_LDB(dst, b, h) do { _Pragma("unroll") for (int n = 0; n < 2; ++n) _Pragma("unroll") for (int k = 0; k < 2; ++k) dst[n][k] = *(const PG8_LAS bf16x8*)(lds + PG8_SB(b, h) + boff + n * 2048 + k * 1024); } while (0)
#define PG8_MMA(ai, bj, At, Bt) do { __builtin_amdgcn_s_setprio(1); _Pragma("unroll") for (int m = 0; m < 4; ++m) _Pragma("unroll") for (int n = 0; n < 2; ++n) _Pragma("unroll") for (int k = 0; k < 2; ++k) \
        acc[ai][bj][m][n] = __builtin_amdgcn_mfma_f32_16x16x32_bf16(Bt[n][k], At[m][k], acc[ai][bj][m][n], 0, 0, 0); __builtin_amdgcn_s_setprio(0); } while (0)
#define PG8_WAIT_V(n) asm volatile("s_waitcnt vmcnt(" #n ")" ::: "memory")
#define PG8_WAIT_L(n) asm volatile("s_waitcnt lgkmcnt(" #n ")" ::: "memory")
#define PG8_BAR __builtin_amdgcn_s_barrier()
#define PG8_SCHED __builtin_amdgcn_sched_barrier(0)
    Unit cur, nxt; int ui = 0;
    if (!S.next(0, cur)) return;
    f32x4 acc[2][2][4][2];
#pragma unroll
    for (int a = 0; a < 2; ++a)
#pragma unroll
        for (int b = 0; b < 2; ++b)
#pragma unroll
            for (int m = 0; m < 4; ++m)
#pragma unroll
                for (int n = 0; n < 2; ++n) acc[a][b][m][n] = (f32x4){0.f, 0.f, 0.f, 0.f};
    bf16x8 At[4][2], B0[2][2], B1[2][2];
    const char* cA = (const char*)g.A + (size_t)cur.pm * tstep; const char* cB = (const char*)g.Bt + (size_t)cur.pn * tstep;
    S.a_ready(cur);
    if constexpr (SP2) {
        PG8_STAGE(PG8_SB(0, 0), cB, voffB); PG8_STAGE(PG8_SB(0, 1), cB + hstep, voffB); PG8_STAGE(PG8_SA(0, 0), cA, voffA); PG8_STAGE(PG8_SA(0, 1), cA + hstep, voffA);
        if (wr == 1) PG8_BAR;
        PG8_WAIT_V(2); PG8_BAR;
        PG8_STAGE(PG8_SB(1, 0), cB + kstep, voffB); PG8_STAGE(PG8_SA(1, 0), cA + kstep, voffA); PG8_STAGE(PG8_SB(1, 1), cB + hstep + kstep, voffB);
        PG8_WAIT_V(6); PG8_BAR;
    } else {
        PG8_STAGE(PG8_SB(0, 0), cB, voffB); PG8_STAGE(PG8_SA(0, 0), cA, voffA); PG8_STAGE(PG8_SB(0, 1), cB + hstep, voffB); PG8_STAGE(PG8_SA(0, 1), cA + hstep, voffA);
        if (wr == 1) PG8_BAR;
        PG8_WAIT_V(4); PG8_BAR;
        PG8_STAGE(PG8_SB(1, 0), cB + kstep, voffB); PG8_STAGE(PG8_SA(1, 0), cA + kstep, voffA); PG8_STAGE(PG8_SB(1, 1), cB + hstep + kstep, voffB);
        PG8_WAIT_V(6); PG8_BAR;
    }
    for (;;) {
        const bool has_next = S.next(ui + 1, nxt);
        const char* nA = has_next ? (const char*)g.A + (size_t)nxt.pm * tstep : cA; const char* nB = has_next ? (const char*)g.Bt + (size_t)nxt.pn * tstep : cB;
        for (int t = 0; t < nt; t += 2) {
            const bool last = (t == nt - 2);
            const char* a1 = cA + (size_t)(t + 1) * kstep;
            const char* a2 = last ? nA : cA + (size_t)(t + 2) * kstep; const char* b2 = last ? nB : cB + (size_t)(t + 2) * kstep;
            const char* a3 = a2 + kstep; const char* b3 = b2 + kstep;
            if (last && has_next) S.a_ready(nxt);
            if constexpr (SP2) {
            PG8_LDB(B0, 0, 0); PG8_LDB(B1, 0, 1); PG8_SCHED; PG8_LDA(At, 0, 0); PG8_STAGE(PG8_SA(1, 1), a1 + hstep, voffA);
            PG8_WAIT_V(8); PG8_WAIT_L(0); PG8_BAR; PG8_MMA(0, 0, At, B0); PG8_MMA(0, 1, At, B1); PG8_BAR; PG8_SCHED;
            PG8_LDA(At, 0, 1); PG8_STAGE(PG8_SB(0, 0), b2, voffB); PG8_STAGE(PG8_SB(0, 1), b2 + hstep, voffB); PG8_STAGE(PG8_SA(0, 0), a2, voffA);
            PG8_WAIT_V(8); PG8_WAIT_L(0); PG8_BAR; PG8_MMA(1, 0, At, B0); PG8_MMA(1, 1, At, B1); PG8_BAR; PG8_SCHED;
            PG8_LDB(B0, 1, 0); PG8_LDB(B1, 1, 1); PG8_SCHED; PG8_LDA(At, 1, 0); PG8_STAGE(PG8_SA(0, 1), a2 + hstep, voffA);
            PG8_WAIT_V(8); PG8_WAIT_L(0); PG8_BAR; PG8_MMA(0, 0, At, B0); PG8_MMA(0, 1, At, B1); PG8_BAR; PG8_SCHED;
            PG8_LDA(At, 1, 1); PG8_STAGE(PG8_SB(1, 0), b3, voffB); PG8_STAGE(PG8_SB(1, 1), b3 + hstep, voffB); PG8_STAGE(PG8_SA(1, 0), a3, voffA);
            PG8_WAIT_V(8); PG8_WAIT_L(0); PG8_BAR; PG8_MMA(1, 0, At, B0); PG8_MMA(1, 1, At, B1); PG8_BAR; PG8_SCHED;
            } else {
            PG8_LDB(B0, 0, 0); PG8_SCHED; PG8_LDA(At, 0, 0); PG8_STAGE(PG8_SA(1, 1), a1 + hstep, voffA);
            PG8_WAIT_L(8); PG8_BAR; PG8_WAIT_L(0); PG8_MMA(0, 0, At, B0); PG8_BAR; PG8_SCHED;
            PG8_LDB(B1, 0, 1); PG8_STAGE(PG8_SB(0, 0), b2, voffB);
            PG8_BAR; PG8_WAIT_L(0); PG8_MMA(0, 1, At, B1); PG8_BAR;
            PG8_LDA(At, 0, 1); PG8_STAGE(PG8_SA(0, 0), a2, voffA);
            PG8_BAR; PG8_WAIT_L(0); PG8_MMA(1, 0, At, B0); PG8_BAR; PG8_SCHED;
            PG8_STAGE(PG8_SB(0, 1), b2 + hstep, voffB);
            PG8_WAIT_V(6); PG8_BAR; PG8_MMA(1, 1, At, B1); PG8_BAR;
            PG8_LDB(B0, 1, 0); PG8_SCHED; PG8_LDA(At, 1, 0); PG8_STAGE(PG8_SA(0, 1), a2 + hstep, voffA);
            PG8_WAIT_L(8); PG8_BAR; PG8_WAIT_L(0); PG8_MMA(0, 0, At, B0); PG8_BAR; PG8_SCHED;
            PG8_LDB(B1, 1, 1); PG8_STAGE(PG8_SB(1, 0), b3, voffB);
            PG8_BAR; PG8_WAIT_L(0); PG8_MMA(0, 1, At, B1); PG8_BAR;
            PG8_LDA(At, 1, 1); PG8_STAGE(PG8_SA(1, 0), a3, voffA);
            PG8_BAR; PG8_WAIT_L(0); PG8_MMA(1, 0, At, B0); PG8_BAR; PG8_SCHED;
            PG8_STAGE(PG8_SB(1, 1), b3 + hstep, voffB);
            PG8_WAIT_V(6); PG8_BAR; PG8_MMA(1, 1, At, B1); PG8_BAR;
            }
        }
        if constexpr (ALIGN_EPI) { if (wr == 0) PG8_BAR; }
        if constexpr (!Epi::AFTER_DRAIN) { E(acc, cur, wr, wc, fr, fq); S.done(cur); }
        if (!has_next) break;
#pragma unroll
        for (int a = 0; a < 2; ++a)
#pragma unroll
            for (int b = 0; b < 2; ++b)
#pragma unroll
                for (int m = 0; m < 4; ++m)
#pragma unroll
                    for (int n = 0; n < 2; ++n) acc[a][b][m][n] = (f32x4){0.f, 0.f, 0.f, 0.f};
        cur = nxt; cA = nA; cB = nB; ++ui;
        if constexpr (ALIGN_EPI) { if (wr == 1) PG8_BAR; }
    }
    PG8_WAIT_V(0);
    if constexpr (!ALIGN_EPI) { if (wr == 0) PG8_BAR; }
    PG8_BAR;
    if constexpr (Epi::AFTER_DRAIN) { E.fused(acc, cur, wr, wc, fr, fq, lds, wid, lane); S.done(cur); }
#undef PG8_SA
#undef PG8_SB
#undef PG8_STAGE
#undef PG8_LDA
#undef PG8_LDB
#undef PG8_MMA
#undef PG8_WAIT_V
#undef PG8_WAIT_L
#undef PG8_BAR
#undef PG8_SCHED
}
}

#define LAS __attribute__((address_space(3)))
using pg8::bf16_t; using pg8::bf16x8; using pg8::f32x4; using pg8::u32x4; using pg8::Unit; using pg8::cvt_pk_bf16;
typedef float f32x16 __attribute__((ext_vector_type(16)));
typedef short v4i16_t __attribute__((ext_vector_type(4)));
typedef unsigned u32x2 __attribute__((ext_vector_type(2)));

constexpr int T = 81920, TP = 16384, SS = 2048, DM = 1024, FF = 2816, CH = 40960;
constexpr float EPS = 1e-6f, LOG2E = 1.4426950408889634f;
constexpr size_t MiB = 1u << 20;
constexpr size_t W_GU1 = 0, W_D1 = W_GU1 + 5632ull * 1024 * 2, W_GU2 = W_D1 + 1024ull * 2816 * 2, W_D2 = W_GU2 + 5632ull * 1024 * 2,
                 W_DIL = W_D2 + 1024ull * 2816 * 2, W_A = W_DIL + 4608ull * 1024 * 2, W_UQ = W_A + 1024ull * 1024 * 2, W_UKV = W_UQ + 2048ull * 512 * 2,
                 W_G = W_UKV + 2048ull * 256 * 2, W_OA = W_G + 2048ull * 1024 * 2, W_OB = W_OA + 1024ull * 1024 * 2, W_OUT = W_OB + 1024ull * 512 * 2,
                 W_PG = W_OUT + 1024ull * 1024 * 2, W_PE = W_PG + 1024ull * 1024 * 2, W_END = W_PE + 1024ull * 256 * 2;
static_assert(W_END <= 64 * MiB, "weights");
constexpr size_t S_BASE = 64 * MiB;
constexpr size_t S_RS0 = S_BASE, S_SSQ1 = S_RS0 + (size_t)T * 4, S_SSQ2 = S_SSQ1 + (size_t)T * 64, S_SSQ3 = S_SSQ2 + (size_t)T * 64,
                 S_SSQQ = S_SSQ3 + (size_t)T * 64, S_SSQKV = S_SSQQ + (size_t)T * 32, S_SSQPE = S_SSQKV + (size_t)T * 16, S_KPE = S_SSQPE + (size_t)T * 4,
                 S_L0 = S_KPE + (size_t)T * 256, S_L1 = S_L0 + (size_t)T * 32, S_MCOS = S_L1 + (size_t)T * 32, S_MSIN = S_MCOS + 16384ull * 32 * 4,
                 S_DCOS = S_MSIN + 16384ull * 32 * 4, S_DSIN = S_DCOS + 16384ull * 8 * 4, S_END = S_DSIN + 16384ull * 8 * 4;
constexpr size_t S_CTL = (S_END + 4095) / 4096 * 4096, CTL_BYTES = 16384;
static_assert(S_CTL + CTL_BYTES <= 128 * MiB, "small");
constexpr size_t XB_OFF = 128 * MiB;
constexpr size_t R = 288 * MiB;
constexpr size_t R_H = R, R_DIL = R, R_O0 = R + 240 * MiB, R_O1 = R + 320 * MiB, R_OD = R + 656 * MiB;
constexpr size_t R_Q = R, R_K = R + 120 * MiB, R_V = R + 240 * MiB, R_OM = R + 320 * MiB, R_CQ = R + 480 * MiB, R_CKV = R + 520 * MiB;
constexpr size_t R_GATES = R, R_TT = R + 480 * MiB, R_PB = R + 440 * MiB, R_PEO = R + 480 * MiB;
constexpr size_t WS_NEED = 1024 * MiB;

constexpr int LDS_BYTES = 147456, LDS_SCR = 131072;

struct Params { const float* in[28]; float* out; unsigned char* ws; };
typedef const __attribute__((address_space(4))) Params CParams;
__device__ __forceinline__ const void* uniform_ptr(const void* p) { const unsigned long long v = (unsigned long long)p; const unsigned lo = __builtin_amdgcn_readfirstlane((unsigned)v), hi = __builtin_amdgcn_readfirstlane((unsigned)(v >> 32)); return (const void*)(((unsigned long long)hi << 32) | lo); }

__device__ __forceinline__ int tok_pos(int row) { return row < TP ? row : (row & (SS - 1)); }
__device__ __forceinline__ float fsigmoid(float x) { return __builtin_amdgcn_rcpf(1.f + __builtin_amdgcn_exp2f(-x * LOG2E)); }
__device__ __forceinline__ float rs16(const float* ssq, int row) {
    const float a = __hip_atomic_load(ssq + row, __ATOMIC_RELAXED, __HIP_MEMORY_SCOPE_AGENT), b = __hip_atomic_load(ssq + T + row, __ATOMIC_RELAXED, __HIP_MEMORY_SCOPE_AGENT),
                c = __hip_atomic_load(ssq + 2 * T + row, __ATOMIC_RELAXED, __HIP_MEMORY_SCOPE_AGENT), d = __hip_atomic_load(ssq + 3 * T + row, __ATOMIC_RELAXED, __HIP_MEMORY_SCOPE_AGENT);
    return rsqrtf(((a + b) + (c + d)) * (1.f / 1024.f) + EPS);
}
__device__ __forceinline__ u32x4 pack8(f32x4 a, f32x4 b) { u32x4 w; w.x = cvt_pk_bf16(a[0], a[1]); w.y = cvt_pk_bf16(a[2], a[3]); w.z = cvt_pk_bf16(b[0], b[1]); w.w = cvt_pk_bf16(b[2], b[3]); return w; }
__device__ __forceinline__ float bf_lo(unsigned w) { return __builtin_bit_cast(float, w << 16); }
__device__ __forceinline__ float bf_hi(unsigned w) { return __builtin_bit_cast(float, w & 0xffff0000u); }
__device__ __forceinline__ float dot4(f32x4 v) { return (v[0] * v[0] + v[1] * v[1]) + (v[2] * v[2] + v[3] * v[3]); }
__device__ __forceinline__ float quad_sum(float s) { s += __shfl_xor(s, 16); s += __shfl_xor(s, 32); return s; }

#define EPI_ROWS(ai, m) (u.pm * 256 + (ai) * 128 + wr * 64 + (m) * 16 + fr)
typedef f32x4 (&AccRef)[2][2][4][2];

struct EpiSwiglu {
    static constexpr bool PERM = true, AFTER_DRAIN = false;
    const float* rs_direct; const float* ssq16; bf16_t* H;
    __device__ __forceinline__ void operator()(AccRef acc, const Unit& u, int wr, int wc, int fr, int fq) const {
        asm volatile("" : "+v"(fr), "+v"(fq));
#pragma unroll
        for (int ai = 0; ai < 2; ++ai)
#pragma unroll
            for (int m = 0; m < 4; ++m) { asm volatile("" ::: "memory");
                const int row = EPI_ROWS(ai, m); const float rs = rs_direct ? rs_direct[row] : rs16(ssq16, row);
                f32x4 h[2];
                const float nrl = -rs * LOG2E, rs2 = rs * rs;
#pragma unroll
                for (int n = 0; n < 2; ++n) { const f32x4 g = acc[ai][0][m][n], up = acc[ai][1][m][n];
#pragma unroll
                    for (int e = 0; e < 4; ++e) h[n][e] = (g[e] * up[e]) * (rs2 * __builtin_amdgcn_rcpf(1.f + __builtin_amdgcn_exp2f(g[e] * nrl))); }
                *(u32x4*)(H + (size_t)row * FF + u.pn * 128 + wc * 32 + fq * 8) = pack8(h[0], h[1]);
            }
    }
};
template <bool RESBF> struct EpiResid {
    static constexpr bool PERM = true, AFTER_DRAIN = false;
    const float* resA; const float* resB; bf16_t* xb; float* ssq; float scale; LAS float* scr;
    __device__ __forceinline__ void operator()(AccRef acc, const Unit& u, int wr, int wc, int fr, int fq) const {
        asm volatile("" : "+v"(fr), "+v"(fq));
#pragma unroll
        for (int ai = 0; ai < 2; ++ai)
#pragma unroll
            for (int m = 0; m < 4; ++m) { asm volatile("" ::: "memory");
                const int row = EPI_ROWS(ai, m); const float* rp = row < TP ? resA + (size_t)row * DM : resB + (size_t)(row - TP) * DM;
                float part = 0.f;
#pragma unroll
                for (int bj = 0; bj < 2; ++bj) { const int col0 = u.pn * 256 + bj * 128 + wc * 32 + fq * 8; f32x4 v[2];
                    if (RESBF) { const u32x4 p = *(const u32x4*)(xb + (size_t)row * DM + col0);
                        v[0] = (f32x4){bf_lo(p.x), bf_hi(p.x), bf_lo(p.y), bf_hi(p.y)} + acc[ai][bj][m][0] * scale; v[1] = (f32x4){bf_lo(p.z), bf_hi(p.z), bf_lo(p.w), bf_hi(p.w)} + acc[ai][bj][m][1] * scale;
                    } else {
#pragma unroll
                        for (int n = 0; n < 2; ++n) v[n] = *(const f32x4*)(rp + col0 + 4 * n) + acc[ai][bj][m][n] * scale; }
                    part += dot4(v[0]) + dot4(v[1]);
                    *(u32x4*)(xb + (size_t)row * DM + col0) = pack8(v[0], v[1]); }
                part = quad_sum(part);
                if (fq == 0) scr[(ai * 128 + wr * 64 + m * 16 + fr) * 4 + wc] = part;
            }
        asm volatile("s_waitcnt lgkmcnt(0)" ::: "memory"); __builtin_amdgcn_s_barrier(); asm volatile("" ::: "memory");
        if (wc == 0 && fq == 0) {
#pragma unroll
            for (int ai = 0; ai < 2; ++ai)
#pragma unroll
                for (int m = 0; m < 4; ++m) { const f32x4 pp = *(const LAS f32x4*)(scr + (ai * 128 + wr * 64 + m * 16 + fr) * 4);
                    ssq[(size_t)u.pn * T + EPI_ROWS(ai, m)] = (pp[0] + pp[1]) + (pp[2] + pp[3]); }
        }
    }
};
struct EpiDil {
    static constexpr bool PERM = true, AFTER_DRAIN = false;
    const float* ssq16; const float* gq; const float* gk; const float* dcos; const float* dsin; bf16_t* out;
    __device__ __forceinline__ void operator()(AccRef acc, const Unit& u, int wr, int wc, int fr, int fq) const {
        asm volatile("" : "+v"(fr), "+v"(fq));
        const int s = u.pn >> 1, h = (u.pn & 1) * 4 + wc;
        f32x4 g4[2][2];
        if (s < 2) { const float* gp = s == 0 ? gq : gk;
#pragma unroll
            for (int bj = 0; bj < 2; ++bj)
#pragma unroll
                for (int n = 0; n < 2; ++n) { const int d0 = (bj == 0 && fq < 2) ? 4 * fq + 8 * n : bj * 32 + 8 * fq + 4 * n; g4[bj][n] = *(const f32x4*)(gp + d0); } }
#pragma unroll
        for (int ai = 0; ai < 2; ++ai)
#pragma unroll
            for (int m = 0; m < 4; ++m) { asm volatile("" ::: "memory");
                const int row = EPI_ROWS(ai, m); const float rs = rs16(ssq16, row);
                f32x4 v[2][2]; float part = 0.f;
#pragma unroll
                for (int bj = 0; bj < 2; ++bj)
#pragma unroll
                    for (int n = 0; n < 2; ++n) { v[bj][n] = acc[ai][bj][m][n] * rs; part += dot4(v[bj][n]); }
                if (s < 2) {
                    part = quad_sum(part);
                    float rn = rsqrtf(part * (1.f / 64.f) + EPS); if (s == 0) rn *= 0.125f * LOG2E;
#pragma unroll
                    for (int bj = 0; bj < 2; ++bj)
#pragma unroll
                        for (int n = 0; n < 2; ++n) v[bj][n] = v[bj][n] * rn * g4[bj][n];
                    if (fq < 2) { const int pos = tok_pos(row); const f32x4 c = *(const f32x4*)(dcos + pos * 8 + 4 * fq), sn = *(const f32x4*)(dsin + pos * 8 + 4 * fq);
                        const f32x4 x1 = v[0][0], x2 = v[0][1]; v[0][0] = x1 * c - x2 * sn; v[0][1] = x2 * c + x1 * sn; }
                }
                bf16_t* o = out + (size_t)row * 1536 + s * 512 + h * 64 + fq * 8;
                *(u32x4*)(o) = pack8(v[0][0], v[0][1]); *(u32x4*)(o + 32) = pack8(v[1][0], v[1][1]);
            }
    }
};
struct EpiA {
    static constexpr bool PERM = true, AFTER_DRAIN = false;
    const float* ssq16; bf16_t* CQ; bf16_t* CKV; float* SSQQ; float* SSQKV; float* SSQPE; float* KPE; const float* gk; const float* mcos; const float* msin; int row0; LAS float* scr;
    __device__ __forceinline__ void operator()(AccRef acc, const Unit& u, int wr, int wc, int fr, int fq) const {
        asm volatile("" : "+v"(fr), "+v"(fq));
        const int pn = u.pn;
        if (!(pn == 3 && wc != 0)) {
#pragma unroll
        for (int ai = 0; ai < 2; ++ai)
#pragma unroll
            for (int m = 0; m < 4; ++m) { asm volatile("" ::: "memory");
                const int lrow = EPI_ROWS(ai, m), grow = row0 + lrow; const float rs = rs16(ssq16, grow);
                f32x4 v[2][2]; float part = 0.f;
#pragma unroll
                for (int bj = 0; bj < 2; ++bj)
#pragma unroll
                    for (int n = 0; n < 2; ++n) { v[bj][n] = acc[ai][bj][m][n] * rs; part += dot4(v[bj][n]); }
                part = quad_sum(part);
                if (pn < 2) {
                    bf16_t* o = CQ + (size_t)lrow * 512 + pn * 256 + wc * 32 + fq * 8;
                    *(u32x4*)o = pack8(v[0][0], v[0][1]); *(u32x4*)(o + 128) = pack8(v[1][0], v[1][1]);
                } else if (pn == 2) {
                    bf16_t* o = CKV + (size_t)lrow * 256 + wc * 32 + fq * 8;
                    *(u32x4*)o = pack8(v[0][0], v[0][1]); *(u32x4*)(o + 128) = pack8(v[1][0], v[1][1]);
                } else {
                    if (fq == 0) SSQPE[grow] = part;
                    const int pos = tok_pos(grow);
#pragma unroll
                    for (int n = 0; n < 2; ++n) { const int i0 = 8 * fq + 4 * n;
                        const f32x4 a = v[0][n] * *(const f32x4*)(gk + 128 + i0), b = v[1][n] * *(const f32x4*)(gk + 160 + i0);
                        const f32x4 c = *(const f32x4*)(mcos + pos * 32 + i0), sn = *(const f32x4*)(msin + pos * 32 + i0);
                        *(f32x4*)(KPE + (size_t)grow * 64 + i0) = a * c - b * sn; *(f32x4*)(KPE + (size_t)grow * 64 + 32 + i0) = b * c + a * sn; }
                }
                if (fq == 0) scr[(ai * 128 + wr * 64 + m * 16 + fr) * 4 + wc] = part;
            }
        }
        asm volatile("s_waitcnt lgkmcnt(0)" ::: "memory"); __builtin_amdgcn_s_barrier(); asm volatile("" ::: "memory");
        if (pn < 3 && wc == 0 && fq == 0) {
#pragma unroll
            for (int ai = 0; ai < 2; ++ai)
#pragma unroll
                for (int m = 0; m < 4; ++m) { const f32x4 pp = *(const LAS f32x4*)(scr + (ai * 128 + wr * 64 + m * 16 + fr) * 4); const float tot = (pp[0] + pp[1]) + (pp[2] + pp[3]);
                    const int grow = row0 + EPI_ROWS(ai, m);
                    if (pn < 2) SSQQ[(size_t)pn * T + grow] = tot; else SSQKV[grow] = tot; }
        }
    }
};
struct EpiQ {
    static constexpr bool PERM = true, AFTER_DRAIN = false;
    const float* SSQQ; const float* gq; const float* mcos; const float* msin; bf16_t* Q; LAS float* scr; int row0;
    __device__ __forceinline__ void operator()(AccRef acc, const Unit& u, int wr, int wc, int fr, int fq) const {
        asm volatile("" : "+v"(fr), "+v"(fq));
        const int h = u.pn;
#pragma unroll
        for (int ai = 0; ai < 2; ++ai)
#pragma unroll
            for (int m = 0; m < 4; ++m) { asm volatile("" ::: "memory");
                const int grow = row0 + EPI_ROWS(ai, m);
                const float rq = rsqrtf((SSQQ[grow] + SSQQ[T + grow]) * (1.f / 512.f) + EPS);
                float part = 0.f;
#pragma unroll
                for (int bj = 0; bj < 2; ++bj)
#pragma unroll
                    for (int n = 0; n < 2; ++n) { acc[ai][bj][m][n] = acc[ai][bj][m][n] * rq; part += dot4(acc[ai][bj][m][n]); }
                part = quad_sum(part);
                if (fq == 0) scr[(ai * 128 + wr * 64 + m * 16 + fr) * 4 + wc] = part;
            }
        asm volatile("s_waitcnt lgkmcnt(0)" ::: "memory"); __builtin_amdgcn_s_barrier(); asm volatile("" ::: "memory");
        if (wc == 3) return;
        f32x4 g4[2][2];
#pragma unroll
        for (int bj = 0; bj < 2; ++bj)
#pragma unroll
            for (int n = 0; n < 2; ++n) g4[bj][n] = *(const f32x4*)(gq + wc * 64 + bj * 32 + 8 * fq + 4 * n);
#pragma unroll
        for (int ai = 0; ai < 2; ++ai)
#pragma unroll
            for (int m = 0; m < 4; ++m) { asm volatile("" ::: "memory");
                const int lrow = EPI_ROWS(ai, m), grow = row0 + lrow;
                const f32x4 pp = *(const LAS f32x4*)(scr + (ai * 128 + wr * 64 + m * 16 + fr) * 4);
                const float rn = rsqrtf(((pp[0] + pp[1]) + pp[2]) * (1.f / 192.f) + EPS) * (0.07216878364870322f * LOG2E);
                f32x4 v[2][2];
#pragma unroll
                for (int bj = 0; bj < 2; ++bj)
#pragma unroll
                    for (int n = 0; n < 2; ++n) v[bj][n] = acc[ai][bj][m][n] * rn * g4[bj][n];
                if (wc == 2) { const int pos = tok_pos(grow);
#pragma unroll
                    for (int n = 0; n < 2; ++n) { const int i0 = 8 * fq + 4 * n; const f32x4 c = *(const f32x4*)(mcos + pos * 32 + i0), sn = *(const f32x4*)(msin + pos * 32 + i0);
                        const f32x4 a = v[0][n], b = v[1][n]; v[0][n] = a * c - b * sn; v[1][n] = b * c + a * sn; } }
                bf16_t* o = Q + (size_t)lrow * 1536 + h * 192 + wc * 64 + fq * 8;
                *(u32x4*)o = pack8(v[0][0], v[0][1]); *(u32x4*)(o + 32) = pack8(v[1][0], v[1][1]);
            }
    }
};
struct EpiKV {
    static constexpr bool PERM = true, AFTER_DRAIN = false;
    const float* SSQKV; const float* SSQPE; const float* KPE; const float* gk; bf16_t* K; bf16_t* V; LAS float* scr; int row0;
    __device__ __forceinline__ void operator()(AccRef acc, const Unit& u, int wr, int wc, int fr, int fq) const {
        asm volatile("" : "+v"(fr), "+v"(fq));
        const int h = u.pn;
#pragma unroll
        for (int ai = 0; ai < 2; ++ai)
#pragma unroll
            for (int m = 0; m < 4; ++m) { asm volatile("" ::: "memory");
                const int grow = row0 + EPI_ROWS(ai, m);
                const float rkv = rsqrtf(SSQKV[grow] * (1.f / 256.f) + EPS);
                float part = 0.f;
#pragma unroll
                for (int bj = 0; bj < 2; ++bj)
#pragma unroll
                    for (int n = 0; n < 2; ++n) { acc[ai][bj][m][n] = acc[ai][bj][m][n] * rkv; part += dot4(acc[ai][bj][m][n]); }
                part = quad_sum(part);
                if (fq == 0 && wc < 2) scr[(ai * 128 + wr * 64 + m * 16 + fr) * 2 + wc] = part;
            }
        asm volatile("s_waitcnt lgkmcnt(0)" ::: "memory"); __builtin_amdgcn_s_barrier(); asm volatile("" ::: "memory");
        float rn[2][4];
#pragma unroll
        for (int ai = 0; ai < 2; ++ai)
#pragma unroll
            for (int m = 0; m < 4; ++m) { const int grow = row0 + EPI_ROWS(ai, m); const int rl = ai * 128 + wr * 64 + m * 16 + fr;
                rn[ai][m] = rsqrtf((scr[rl * 2] + scr[rl * 2 + 1] + SSQPE[grow]) * (1.f / 192.f) + EPS); }
        if (wc < 2) {
#pragma unroll
            for (int bj = 0; bj < 2; ++bj) {
                const f32x4 g0 = *(const f32x4*)(gk + wc * 64 + bj * 32 + 8 * fq), g1 = *(const f32x4*)(gk + wc * 64 + bj * 32 + 8 * fq + 4);
#pragma unroll
                for (int ai = 0; ai < 2; ++ai)
#pragma unroll
                    for (int m = 0; m < 4; ++m) { const int lrow = EPI_ROWS(ai, m);
                        *(u32x4*)(K + (size_t)lrow * 1536 + h * 192 + wc * 64 + bj * 32 + fq * 8) = pack8(acc[ai][bj][m][0] * rn[ai][m] * g0, acc[ai][bj][m][1] * rn[ai][m] * g1); }
                asm volatile("" ::: "memory");
            }
        } else {
#pragma unroll
            for (int ai = 0; ai < 2; ++ai)
#pragma unroll
                for (int m = 0; m < 4; ++m) { asm volatile("" ::: "memory");
                    const int lrow = EPI_ROWS(ai, m), grow = row0 + lrow;
                    bf16_t* o = V + (size_t)lrow * 1024 + h * 128 + (wc - 2) * 64 + fq * 8;
                    *(u32x4*)o = pack8(acc[ai][0][m][0], acc[ai][0][m][1]); *(u32x4*)(o + 32) = pack8(acc[ai][1][m][0], acc[ai][1][m][1]);
                    const int j0 = (wc - 2) * 32 + fq * 8; const f32x4 k0 = *(const f32x4*)(KPE + (size_t)grow * 64 + j0), k1 = *(const f32x4*)(KPE + (size_t)grow * 64 + j0 + 4);
                    *(u32x4*)(K + (size_t)lrow * 1536 + h * 192 + 128 + j0) = pack8(k0 * rn[ai][m], k1 * rn[ai][m]); }
        }
    }
};
template <int MODE> struct EpiEW {
    static constexpr bool PERM = true, AFTER_DRAIN = false;
    const float* ssq16; const bf16_t* aux; int ldaux; bf16_t* out; int ldo;
    __device__ __forceinline__ void operator()(AccRef acc, const Unit& u, int wr, int wc, int fr, int fq) const {
        asm volatile("" : "+v"(fr), "+v"(fq));
#pragma unroll
        for (int ai = 0; ai < 2; ++ai)
#pragma unroll
            for (int m = 0; m < 4; ++m) { asm volatile("" ::: "memory");
                const int row = EPI_ROWS(ai, m); float rs = 1.f; if (MODE == 0 || MODE == 5) rs = rs16(ssq16, row);
#pragma unroll
                for (int bj = 0; bj < 2; ++bj) { const int col0 = u.pn * 256 + bj * 128 + wc * 32 + fq * 8; f32x4 v[2] = {acc[ai][bj][m][0], acc[ai][bj][m][1]};
                    if (MODE == 0 || MODE == 4) {
#pragma unroll
                        for (int n = 0; n < 2; ++n)
#pragma unroll
                            for (int e = 0; e < 4; ++e) v[n][e] = __builtin_amdgcn_rcpf(1.f + __builtin_amdgcn_exp2f(v[n][e] * (-rs * LOG2E)));
                    } else if (MODE == 5) { v[0] = v[0] * rs; v[1] = v[1] * rs;
                    } else if (MODE == 1 || MODE == 2) {
                        const u32x4 g = *(const u32x4*)(aux + (size_t)row * ldaux + col0);
                        const f32x4 ga = {bf_lo(g.x), bf_hi(g.x), bf_lo(g.y), bf_hi(g.y)}, gb = {bf_lo(g.z), bf_hi(g.z), bf_lo(g.w), bf_hi(g.w)};
                        v[0] = v[0] * ga; v[1] = v[1] * gb;
                        if (MODE == 2) { const u32x4 p = *(const u32x4*)(out + (size_t)row * ldo + col0);
                            v[0] = v[0] + (f32x4){bf_lo(p.x), bf_hi(p.x), bf_lo(p.y), bf_hi(p.y)}; v[1] = v[1] + (f32x4){bf_lo(p.z), bf_hi(p.z), bf_lo(p.w), bf_hi(p.w)}; }
                    }
                    *(u32x4*)(out + (size_t)row * ldo + col0) = pack8(v[0], v[1]); }
            }
    }
};
struct EpiFinal {
    static constexpr bool PERM = true, AFTER_DRAIN = false;
    const float* ssq16; const bf16_t* pe; const bf16_t* xb; float* out;
    __device__ __forceinline__ void operator()(AccRef acc, const Unit& u, int wr, int wc, int fr, int fq) const {
        asm volatile("" : "+v"(fr), "+v"(fq));
#pragma unroll
        for (int ai = 0; ai < 2; ++ai)
#pragma unroll
            for (int m = 0; m < 4; ++m) { asm volatile("" ::: "memory");
                const int row = EPI_ROWS(ai, m); const float rs = rs16(ssq16, row);
#pragma unroll
                for (int bj = 0; bj < 2; ++bj) { const int col0 = u.pn * 256 + bj * 128 + wc * 32 + fq * 8;
                    const u32x4 g = *(const u32x4*)(pe + (size_t)row * DM + col0), p = *(const u32x4*)(xb + (size_t)row * DM + col0);
                    const f32x4 pa = {bf_lo(g.x), bf_hi(g.x), bf_lo(g.y), bf_hi(g.y)}, pb = {bf_lo(g.z), bf_hi(g.z), bf_lo(g.w), bf_hi(g.w)};
                    f32x4 x0 = {bf_lo(p.x), bf_hi(p.x), bf_lo(p.y), bf_hi(p.y)}, x1 = {bf_lo(p.z), bf_hi(p.z), bf_lo(p.w), bf_hi(p.w)};
                    float* o = out + (size_t)row * DM + col0;
#pragma unroll
                    for (int e = 0; e < 4; ++e) { x0[e] += __builtin_amdgcn_rcpf(1.f + __builtin_amdgcn_exp2f(acc[ai][bj][m][0][e] * (-rs * LOG2E))) * pa[e]; x1[e] += __builtin_amdgcn_rcpf(1.f + __builtin_amdgcn_exp2f(acc[ai][bj][m][1][e] * (-rs * LOG2E))) * pb[e]; }
                    *(f32x4*)o = x0; *(f32x4*)(o + 4) = x1; }
            }
    }
};

template <class E> __device__ __forceinline__ void run_gemm(LAS unsigned char* lds, const bf16_t* A, const bf16_t* Bt, int M, int N, int K, const E& e) {
    A = (const bf16_t*)uniform_ptr(A); Bt = (const bf16_t*)uniform_ptr(Bt);
    pg8::Gemm g{A, Bt, M, N, K}; pg8::StaticOrder S; S.init(M, N, (int)gridDim.x, (int)blockIdx.x);
    pg8::gemm_phase<E, pg8::StaticOrder, true, true>(lds, g, S, e);
}

struct WDesc { const float* src; const float* src2; const float* gain; bf16_t* dst; int K, Nsrc, Ndst, map; };
__device__ __forceinline__ int wcolmap(int map, int n, int& which) {
    which = 0;
    const int tp = n & 255, bj = tp >> 7, wc = (tp >> 5) & 3, c = tp & 31;
    switch (map) {
    case 0: return n;
    case 1: which = bj; return (n >> 8) * 128 + (tp & 127);
    case 2: { const int g = n / 1536, nn = n - g * 1536, pn = nn >> 8, s = pn >> 1, hh = pn & 1, h = hh * 4 + wc, p = bj * 32 + c;
              const int d = (s < 2 && p < 16) ? (4 * (p >> 3) + 8 * ((p >> 2) & 1) + (p & 3)) : p; return 832 + g * 1536 + s * 512 + h * 64 + d; }
    case 3: { if (n < 768) return n; const int t = n - 768; if (t < 32) return 768 + t; if (t >= 128 && t < 160) return 800 + (t - 128); return -1; }
    case 4: { if (wc == 3) return -1; return (n >> 8) * 192 + wc * 64 + bj * 32 + c; }
    case 5: { const int h = n >> 8; return wc < 2 ? h * 256 + wc * 64 + bj * 32 + c : h * 256 + 128 + (wc - 2) * 64 + bj * 32 + c; }
    case 6: return 5440 + n;
    }
    return -1;
}
__device__ __forceinline__ void transpose_item(const WDesc& d, LAS float* scr, int item, int lane) {
    const int nblk = d.Ndst / 32, kb = item / nblk, nb = item - kb * nblk, k0 = 64 * kb, n0 = 32 * nb;
    int which; const int col = wcolmap(d.map, n0 + (lane & 31), which); const bool up = (d.map == 1) && (((n0 >> 7) & 1) != 0); const float* src = (const float*)uniform_ptr(up ? d.src2 : d.src);
    float tv[32];
#pragma unroll
    for (int i = 0; i < 32; ++i) { const int kk = 2 * i + (lane >> 5); float v = 0.f; if (col >= 0) { v = src[(size_t)(k0 + kk) * d.Nsrc + col]; } tv[i] = v; }
#pragma unroll
    for (int i = 0; i < 32; ++i) { const int kk = 2 * i + (lane >> 5); float v = tv[i]; if (d.gain) v *= d.gain[k0 + kk]; scr[kk * 33 + (lane & 31)] = v; }
    asm volatile("s_waitcnt lgkmcnt(0)" ::: "memory");
    const int c = lane & 7;
#pragma unroll
    for (int j = 0; j < 4; ++j) { const int n = (lane >> 3) + 8 * j; const LAS float* s = scr + (8 * c) * 33 + n;
        u32x4 o; o.x = cvt_pk_bf16(s[0 * 33], s[1 * 33]); o.y = cvt_pk_bf16(s[2 * 33], s[3 * 33]); o.z = cvt_pk_bf16(s[4 * 33], s[5 * 33]); o.w = cvt_pk_bf16(s[6 * 33], s[7 * 33]);
        *(u32x4*)(d.dst + (size_t)(n0 + n) * d.K + k0 + 8 * c) = o; }
    asm volatile("s_waitcnt lgkmcnt(0)" ::: "memory");
}
__device__ __forceinline__ float wave_sum(float v) {
#pragma unroll
    for (int o = 1; o < 64; o <<= 1) v += __shfl_xor(v, o);
    return v;
}
__device__ __forceinline__ void prologue(CParams& P, LAS unsigned char* lds) {
    int tid_ = threadIdx.x; asm volatile("" : "+v"(tid_));
    const int tid = tid_, lane = tid & 63, wave = tid >> 6; const int gw = blockIdx.x * 8 + wave, NGW = gridDim.x * 8;
    LAS float* scr = (LAS float*)(lds + wave * 16384);
    int base = 0; unsigned char* ws = P.ws;
#define WCONV(SRC, SRC2, GAIN, DSTOFF, KK, NSRC, NDST, MAP) { const WDesc d{SRC, SRC2, GAIN, (bf16_t*)(ws + (DSTOFF)), KK, NSRC, NDST, MAP}; constexpr int items = ((KK) / 64) * ((NDST) / 32); \
        for (int it = (gw - base % NGW + NGW) % NGW; it < items; it += NGW) transpose_item(d, scr, it, lane); base += items; asm volatile("" ::: "memory"); }
    WCONV(P.in[5], P.in[6], P.in[4], W_GU1, 1024, 2816, 5632, 1)
    WCONV(P.in[7], nullptr, nullptr, W_D1, 2816, 1024, 1024, 0)
    WCONV(P.in[22], P.in[23], P.in[21], W_GU2, 1024, 2816, 5632, 1)
    WCONV(P.in[24], nullptr, nullptr, W_D2, 2816, 1024, 1024, 0)
    WCONV(P.in[9], nullptr, P.in[8], W_DIL, 1024, 7488, 4608, 2)
    WCONV(P.in[9], nullptr, P.in[8], W_A, 1024, 7488, 1024, 3)
    WCONV(P.in[11], nullptr, P.in[10], W_UQ, 512, 1536, 2048, 4)
    WCONV(P.in[13], nullptr, P.in[12], W_UKV, 256, 2048, 2048, 5)
    WCONV(P.in[9], nullptr, P.in[8], W_G, 1024, 7488, 2048, 6)
    WCONV(P.in[18], nullptr, nullptr, W_OA, 1024, 1024, 1024, 0)
    WCONV(P.in[19], nullptr, nullptr, W_OB, 512, 1024, 1024, 0)
    WCONV(P.in[20], nullptr, nullptr, W_OUT, 1024, 1024, 1024, 0)
    WCONV(P.in[27], nullptr, P.in[25], W_PG, 1024, 1024, 1024, 0)
    WCONV(P.in[26], nullptr, nullptr, W_PE, 256, 1024, 1024, 0)
#undef WCONV
    bf16_t* XB = (bf16_t*)(P.ws + XB_OFF); float* RS0 = (float*)(P.ws + S_RS0);
    for (int m = gw; m < T; m += NGW) { const float* xr = m < TP ? P.in[0] + (size_t)m * DM : P.in[1] + (size_t)(m - TP) * DM;
        f32x4 v[4]; float s = 0.f;
#pragma unroll
        for (int j = 0; j < 4; ++j) { v[j] = ((const f32x4*)xr)[lane + 64 * j]; s += dot4(v[j]); }
        s = wave_sum(s);
#pragma unroll
        for (int j = 0; j < 4; ++j) { u32x2 w; w.x = cvt_pk_bf16(v[j][0], v[j][1]); w.y = cvt_pk_bf16(v[j][2], v[j][3]); ((u32x2*)(XB + (size_t)m * DM))[lane + 64 * j] = w; }
        if (lane == 0) RS0[m] = rsqrtf(s * (1.f / 1024.f) + EPS); }
    float* mcos = (float*)(P.ws + S_MCOS); float* msin = (float*)(P.ws + S_MSIN); float* dcos = (float*)(P.ws + S_DCOS); float* dsin = (float*)(P.ws + S_DSIN);
    const int gt = blockIdx.x * 512 + tid, NT = gridDim.x * 512;
    for (int i = gt; i < 16384 * 40; i += NT) { const bool big = i < 16384 * 32; const int j = big ? i : i - 16384 * 32; const int pos = big ? (j >> 5) : (j >> 3), f = big ? (j & 31) : (j & 7);
        const double inv = exp2(-18.931568569324174 * (double)f / (big ? 32.0 : 8.0)); double xr = (double)pos * inv * 0.15915494309189535; xr -= floor(xr); const float rev = (float)xr;
        const float cs = __builtin_amdgcn_cosf(rev), sn = __builtin_amdgcn_sinf(rev);
        if (big) { mcos[j] = cs; msin[j] = sn; } else { dcos[j] = cs; dsin[j] = sn; } }
}

__device__ __forceinline__ bf16x8 vtr8(const LAS unsigned char* lo, const LAS unsigned char* hi) {
    const v4i16_t a = __builtin_amdgcn_ds_read_tr16_b64_v4i16((LAS v4i16_t*)lo), b = __builtin_amdgcn_ds_read_tr16_b64_v4i16((LAS v4i16_t*)hi);
    return (bf16x8){a[0], a[1], a[2], a[3], b[0], b[1], b[2], b[3]};
}
constexpr int MLA_KP = 400, MLA_KB = 64 * MLA_KP, MLA_VB = 16384, MLA_VOFF = 3 * MLA_KB;
__device__ __forceinline__ void mla_unit(LAS unsigned char* lds, const bf16_t* Qg, const bf16_t* Kg, const bf16_t* Vg, bf16_t* Og, int qrow0, int krow0, int nkt, int h, size_t orow0) {
    int tid_ = threadIdx.x; asm volatile("" : "+v"(tid_));
    const int tid = tid_, lane = tid & 63, wave = tid >> 6, l31 = lane & 31, hi = lane >> 5;
    bf16x8 qf[12];
    { const bf16_t* qp = Qg + (size_t)(qrow0 + wave * 32 + l31) * 1536 + h * 192 + hi * 8;
#pragma unroll
      for (int ks = 0; ks < 12; ++ks) qf[ks] = *(const bf16x8*)(qp + ks * 16); }
    const int skey = tid >> 3, sc8 = tid & 7;
    const bf16_t* kbase = Kg + (size_t)(krow0 + skey) * 1536 + h * 192 + sc8 * 8; const bf16_t* vbase = Vg + (size_t)(krow0 + skey) * 1024 + h * 128 + sc8 * 8;
    const int klds = skey * MLA_KP + sc8 * 16, vlds = MLA_VOFF + ((skey >> 3) * 4 + (sc8 >> 2)) * 512 + (skey & 7) * 64 + (sc8 & 3) * 16;
    u32x4 kr[3], vr[2];
#define MLA_LOADK(t) do { _Pragma("unroll") for (int i = 0; i < 3; ++i) kr[i] = *(const u32x4*)(kbase + (size_t)(t) * (64 * 1536) + i * 64); } while (0)
#define MLA_LOADV(t) do { _Pragma("unroll") for (int i = 0; i < 2; ++i) vr[i] = *(const u32x4*)(vbase + (size_t)(t) * (64 * 1024) + i * 64); } while (0)
#define MLA_STOREK(off) do { _Pragma("unroll") for (int i = 0; i < 3; ++i) *(LAS u32x4*)(lds + (off) + klds + i * 128) = kr[i]; } while (0)
#define MLA_STOREV(off) do { _Pragma("unroll") for (int i = 0; i < 2; ++i) *(LAS u32x4*)(lds + (off) + vlds + i * 1024) = vr[i]; } while (0)
    f32x16 O[4];
#pragma unroll
    for (int dt = 0; dt < 4; ++dt)
#pragma unroll
        for (int r = 0; r < 16; ++r) O[dt][r] = 0.f;
    float mrun = -INFINITY, lrun = 0.f;
    const int koff = l31 * MLA_KP + hi * 16;
    const int voff = MLA_VOFF + (4 * hi + ((lane & 15) >> 2)) * 64 + (((lane >> 4) & 1) * 16 + (lane & 3) * 4) * 2;
    f32x16 sa0, sa1, sb0, sb1; bf16x8 pf[4];
#define MLA_QK(S0, S1, KOFF) do { const LAS unsigned char* sb_ = lds + (KOFF); \
        _Pragma("unroll") for (int r = 0; r < 16; ++r) { S0[r] = 0.f; S1[r] = 0.f; } \
        bf16x8 kq[2][2]; \
        kq[0][0] = *(const LAS bf16x8*)(sb_ + koff); kq[0][1] = *(const LAS bf16x8*)(sb_ + koff + 32 * MLA_KP); \
        _Pragma("unroll") for (int ks = 0; ks < 12; ++ks) { \
            if (ks < 11) { kq[(ks + 1) & 1][0] = *(const LAS bf16x8*)(sb_ + koff + (ks + 1) * 32); kq[(ks + 1) & 1][1] = *(const LAS bf16x8*)(sb_ + koff + 32 * MLA_KP + (ks + 1) * 32); } \
            S0 = __builtin_amdgcn_mfma_f32_32x32x16_bf16(kq[ks & 1][0], qf[ks], S0, 0, 0, 0); S1 = __builtin_amdgcn_mfma_f32_32x32x16_bf16(kq[ks & 1][1], qf[ks], S1, 0, 0, 0); } } while (0)
#define MLA_SM(S0, S1) do { float mx = fmaxf(S0[0], S1[0]); \
        _Pragma("unroll") for (int r = 1; r < 16; ++r) mx = fmaxf(mx, fmaxf(S0[r], S1[r])); \
        { const auto rr_ = __builtin_amdgcn_permlane32_swap(__float_as_uint(mx), __float_as_uint(mx), false, false); mx = fmaxf(__uint_as_float(rr_[0]), __uint_as_float(rr_[1])); } \
        if (__any(mx > mrun)) { const float mnew = fmaxf(mrun, mx), alpha = __builtin_amdgcn_exp2f(mrun - mnew); mrun = mnew; lrun *= alpha; \
            _Pragma("unroll") for (int dt = 0; dt < 4; ++dt) _Pragma("unroll") for (int r = 0; r < 16; ++r) O[dt][r] *= alpha; } \
        float ls = 0.f; \
        _Pragma("unroll") for (int r = 0; r < 16; ++r) { S0[r] = __builtin_amdgcn_exp2f(S0[r] - mrun); S1[r] = __builtin_amdgcn_exp2f(S1[r] - mrun); ls += S0[r] + S1[r]; } \
        lrun += ls; \
        _Pragma("unroll") for (int j = 0; j < 2; ++j) { u32x4 w0, w1; \
            w0.x = cvt_pk_bf16(S0[8 * j + 0], S0[8 * j + 1]); w0.y = cvt_pk_bf16(S0[8 * j + 2], S0[8 * j + 3]); w0.z = cvt_pk_bf16(S0[8 * j + 4], S0[8 * j + 5]); w0.w = cvt_pk_bf16(S0[8 * j + 6], S0[8 * j + 7]); \
            w1.x = cvt_pk_bf16(S1[8 * j + 0], S1[8 * j + 1]); w1.y = cvt_pk_bf16(S1[8 * j + 2], S1[8 * j + 3]); w1.z = cvt_pk_bf16(S1[8 * j + 4], S1[8 * j + 5]); w1.w = cvt_pk_bf16(S1[8 * j + 6], S1[8 * j + 7]); \
            pf[j] = __builtin_bit_cast(bf16x8, w0); pf[2 + j] = __builtin_bit_cast(bf16x8, w1); } } while (0)
#define MLA_PV(VOFFB) do { const LAS unsigned char* sb_ = lds + (VOFFB); bf16x8 vq[2][2]; \
        vq[0][0] = vtr8(sb_ + voff, sb_ + voff + 4 * 512); vq[0][1] = vtr8(sb_ + voff + 512, sb_ + voff + 5 * 512); \
        _Pragma("unroll") for (int st = 0; st < 8; ++st) { const int kg = st >> 1, dp = st & 1; \
            if (st < 7) { const int kg2 = (st + 1) >> 1, dp2 = (st + 1) & 1; \
                vq[(st + 1) & 1][0] = vtr8(sb_ + voff + ((2 * kg2) * 4 + 2 * dp2) * 512, sb_ + voff + ((2 * kg2 + 1) * 4 + 2 * dp2) * 512); \
                vq[(st + 1) & 1][1] = vtr8(sb_ + voff + ((2 * kg2) * 4 + 2 * dp2 + 1) * 512, sb_ + voff + ((2 * kg2 + 1) * 4 + 2 * dp2 + 1) * 512); } \
            O[2 * dp] = __builtin_amdgcn_mfma_f32_32x32x16_bf16(vq[st & 1][0], pf[kg], O[2 * dp], 0, 0, 0); \
            O[2 * dp + 1] = __builtin_amdgcn_mfma_f32_32x32x16_bf16(vq[st & 1][1], pf[kg], O[2 * dp + 1], 0, 0, 0); } } while (0)
#define MLA_STEP(t, SC0, SC1, SN0, SN1) do { const bool more1 = ((t) + 1 < nkt), more2 = ((t) + 2 < nkt); \
        if (more1) { MLA_QK(SN0, SN1, k_nxt); } \
        if (more2) MLA_LOADK((t) + 2); \
        MLA_SM(SC0, SC1); \
        if (more1) MLA_LOADV((t) + 1); \
        MLA_PV(((t) & 1) * MLA_VB); \
        if (more2) MLA_STOREK(k_prv); \
        if (more1) MLA_STOREV((((t) + 1) & 1) * MLA_VB); \
        __syncthreads(); \
        { const int tmp_ = k_prv; k_prv = k_cur; k_cur = k_nxt; k_nxt = tmp_; } } while (0)
    MLA_LOADK(0); MLA_LOADV(0); MLA_STOREK(0); MLA_STOREV(0); MLA_LOADK(1); MLA_STOREK(MLA_KB); __syncthreads();
    int k_cur = 0, k_nxt = MLA_KB, k_prv = 2 * MLA_KB;
    MLA_QK(sa0, sa1, k_cur);
    for (int t = 0; t < nkt; t += 2) {
        MLA_STEP(t, sa0, sa1, sb0, sb1);
        MLA_STEP(t + 1, sb0, sb1, sa0, sa1);
    }
    lrun += __shfl_xor(lrun, 32);
    const float inv = 1.f / lrun;
    bf16_t* op = Og + (orow0 + wave * 32 + l31) * 1024 + h * 128 + 4 * hi;
#pragma unroll
    for (int dt = 0; dt < 4; ++dt)
#pragma unroll
        for (int a = 0; a < 4; ++a) { u32x2 w; w.x = cvt_pk_bf16(O[dt][4 * a] * inv, O[dt][4 * a + 1] * inv); w.y = cvt_pk_bf16(O[dt][4 * a + 2] * inv, O[dt][4 * a + 3] * inv);
            *(u32x2*)(op + dt * 32 + a * 8) = w; }
#undef MLA_LOADK
#undef MLA_LOADV
#undef MLA_STOREK
#undef MLA_STOREV
#undef MLA_QK
#undef MLA_SM
#undef MLA_PV
#undef MLA_STEP
}
__device__ __forceinline__ void mla_phase(LAS unsigned char* lds, CParams& P, int chunk) {
    const bf16_t* Qg = (const bf16_t*)(P.ws + R_Q); const bf16_t* Kg = (const bf16_t*)(P.ws + R_K); const bf16_t* Vg = (const bf16_t*)(P.ws + R_V); bf16_t* Og = (bf16_t*)(P.ws + R_OM);
    const int G = gridDim.x, nbig = chunk == 0 ? 512 : 0, ntot = 1280;
    for (int idx = blockIdx.x; idx < ntot; idx += G) {
        int h, qrow0, krow0, nkt;
        if (idx < nbig) { h = idx & 7; krow0 = 0; qrow0 = (idx >> 3) * 256; nkt = 256; }
        else { const int s = idx - nbig; h = s & 7; const int qb = (s >> 3) & 7, seq = s >> 6; krow0 = (chunk == 0 ? TP : 0) + seq * SS; qrow0 = krow0 + qb * 256; nkt = 32; }
        mla_unit(lds, Qg, Kg, Vg, Og, qrow0, krow0, nkt, h, (size_t)chunk * CH + qrow0);
    }
}

__device__ __forceinline__ void dil_phase(LAS unsigned char* lds, CParams& P, int g) {
    const bf16_t* DIL = (const bf16_t*)(P.ws + R_DIL);
    const int sh = 2 * g, dmask = (1 << sh) - 1;
    int tid_ = threadIdx.x; asm volatile("" : "+v"(tid_));
    const int tid = tid_, lane = tid & 63, wave = tid >> 6, hb = wave >> 2, w = wave & 3, tl = tid & 255, l31 = lane & 31, hi = lane >> 5;
    LAS unsigned char* vb = lds + hb * 32768;
    const int voff = (4 * hi + ((lane & 15) >> 2)) * 64 + (((lane >> 4) & 1) * 16 + (lane & 3) * 4) * 2;
    u32x4 vr[8];
#define DIL_VLOAD(BU) do { const int su_ = 2 * (BU) + hb; int t0_, S_, loc_; \
        if (su_ < 1024) { t0_ = 0; S_ = TP; loc_ = su_; } else { const int s_ = (su_ - 1024) >> 7; t0_ = TP + s_ * SS; S_ = SS; loc_ = (su_ - 1024) & 127; } \
        const int h_ = loc_ & 7, rest_ = loc_ >> 3, r_ = rest_ & dmask, qb_ = rest_ >> sh, L_ = S_ >> sh, subb_ = 128 * qb_ - 64; \
        _Pragma("unroll") for (int i = 0; i < 8; ++i) { const int c = tl + 256 * i, key = c >> 3, ch = c & 7; int sub = subb_ + key; sub = sub < 0 ? 0 : (sub > L_ - 1 ? L_ - 1 : sub); \
            vr[i] = *(const u32x4*)(DIL + (size_t)(t0_ + (sub << sh) + r_) * 1536 + 1024 + h_ * 64 + ch * 8); } } while (0)
    if ((int)blockIdx.x < 2560) DIL_VLOAD((int)blockIdx.x);
    for (int bu = blockIdx.x; bu < 2560; bu += gridDim.x) {
        const int su = 2 * bu + hb; int t0, S, loc;
        if (su < 1024) { t0 = 0; S = TP; loc = su; } else { const int s = (su - 1024) >> 7; t0 = TP + s * SS; S = SS; loc = (su - 1024) & 127; }
        const int h = loc & 7, rest = loc >> 3, r = rest & dmask, qb = rest >> sh, L = S >> sh, sub_b = 128 * qb - 64;
#pragma unroll
        for (int i = 0; i < 8; ++i) { const int c = tl + 256 * i, key = c >> 3, ch = c & 7; *(LAS u32x4*)(vb + ((key >> 3) * 2 + (ch >> 2)) * 512 + (key & 7) * 64 + (ch & 3) * 16) = vr[i]; }
        asm volatile("" ::: "memory");
        const int qsub = 128 * qb + 32 * w + l31; const size_t tokq = (size_t)(t0 + (qsub << sh) + r);
        bf16x8 qf[4];
#pragma unroll
        for (int ks = 0; ks < 4; ++ks) qf[ks] = *(const bf16x8*)(DIL + tokq * 1536 + h * 64 + ks * 16 + hi * 8);
        f32x16 sc[5];
        bf16x8 kfr[5][4];
#pragma unroll
        for (int kt = 0; kt < 5; ++kt) { int sub = sub_b + 32 * w + 32 * kt + l31; sub = sub < 0 ? 0 : (sub > L - 1 ? L - 1 : sub);
            const bf16_t* kp = DIL + (size_t)(t0 + (sub << sh) + r) * 1536 + 512 + h * 64 + hi * 8;
#pragma unroll
            for (int ks = 0; ks < 4; ++ks) kfr[kt][ks] = *(const bf16x8*)(kp + ks * 16); }
        if (bu + (int)gridDim.x < 2560) DIL_VLOAD(bu + (int)gridDim.x);
#pragma unroll
        for (int kt = 0; kt < 5; ++kt) {
#pragma unroll
            for (int r2 = 0; r2 < 16; ++r2) sc[kt][r2] = 0.f;
#pragma unroll
            for (int ks = 0; ks < 4; ++ks) sc[kt] = __builtin_amdgcn_mfma_f32_32x32x16_bf16(kfr[kt][ks], qf[ks], sc[kt], 0, 0, 0);
        }
        float mx = -INFINITY;
#pragma unroll
        for (int kt = 0; kt < 5; ++kt)
#pragma unroll
            for (int r2 = 0; r2 < 16; ++r2) { const int keyl = (r2 & 3) + 8 * (r2 >> 2) + 4 * hi; const int rel = -64 + 32 * kt + keyl - l31; const int ksub = sub_b + 32 * w + 32 * kt + keyl;
                const bool ok = (rel >= -64) && (rel <= 64) && (ksub >= 0) && (ksub < L); sc[kt][r2] = ok ? sc[kt][r2] : -INFINITY; mx = fmaxf(mx, sc[kt][r2]); }
        mx = fmaxf(mx, __shfl_xor(mx, 32));
        float ls = 0.f;
#pragma unroll
        for (int kt = 0; kt < 5; ++kt)
#pragma unroll
            for (int r2 = 0; r2 < 16; ++r2) { sc[kt][r2] = __builtin_amdgcn_exp2f(sc[kt][r2] - mx); ls += sc[kt][r2]; }
        ls += __shfl_xor(ls, 32);
        __syncthreads();
        f32x16 O[2];
#pragma unroll
        for (int dt = 0; dt < 2; ++dt)
#pragma unroll
            for (int r2 = 0; r2 < 16; ++r2) O[dt][r2] = 0.f;
#pragma unroll
        for (int kt = 0; kt < 5; ++kt)
#pragma unroll
            for (int j = 0; j < 2; ++j) {
                u32x4 pw; pw.x = cvt_pk_bf16(sc[kt][8 * j + 0], sc[kt][8 * j + 1]); pw.y = cvt_pk_bf16(sc[kt][8 * j + 2], sc[kt][8 * j + 3]); pw.z = cvt_pk_bf16(sc[kt][8 * j + 4], sc[kt][8 * j + 5]); pw.w = cvt_pk_bf16(sc[kt][8 * j + 6], sc[kt][8 * j + 7]);
                const bf16x8 pf = __builtin_bit_cast(bf16x8, pw); const int kg = 2 * w + 2 * kt + j;
#pragma unroll
                for (int dt = 0; dt < 2; ++dt) { const bf16x8 vf = vtr8(vb + voff + ((2 * kg) * 2 + dt) * 512, vb + voff + ((2 * kg + 1) * 2 + dt) * 512);
                    O[dt] = __builtin_amdgcn_mfma_f32_32x32x16_bf16(vf, pf, O[dt], 0, 0, 0); }
            }
        const float inv = 1.f / ls, lse = mx + __builtin_amdgcn_logf(ls);
        if (g < 2) { bf16_t* Og = (bf16_t*)(P.ws + (g == 0 ? R_O0 : R_O1)); float* Lg = (float*)(P.ws + (g == 0 ? S_L0 : S_L1));
#pragma unroll
            for (int dt = 0; dt < 2; ++dt)
#pragma unroll
                for (int a = 0; a < 4; ++a) { u32x2 wv; wv.x = cvt_pk_bf16(O[dt][4 * a] * inv, O[dt][4 * a + 1] * inv); wv.y = cvt_pk_bf16(O[dt][4 * a + 2] * inv, O[dt][4 * a + 3] * inv);
                    *(u32x2*)(Og + tokq * 512 + h * 64 + dt * 32 + a * 8 + 4 * hi) = wv; }
            if (hi == 0) Lg[(size_t)h * T + t0 + r * L + qsub] = lse;
        } else { bf16_t* Og = (bf16_t*)(P.ws + R_OD); const bf16_t* O0 = (const bf16_t*)(P.ws + R_O0); const bf16_t* O1 = (const bf16_t*)(P.ws + R_O1); const float* L0 = (const float*)(P.ws + S_L0); const float* L1 = (const float*)(P.ws + S_L1);
            const int pos = (qsub << sh) + r; const float l0 = L0[(size_t)h * T + t0 + pos], l1 = L1[(size_t)h * T + t0 + (pos & 3) * (S >> 2) + (pos >> 2)]; const float mm = fmaxf(fmaxf(l0, l1), lse);
            float w0 = __builtin_amdgcn_exp2f(l0 - mm), w1 = __builtin_amdgcn_exp2f(l1 - mm), w2 = __builtin_amdgcn_exp2f(lse - mm); const float wi = 1.f / (w0 + w1 + w2);
            w0 *= wi; w1 *= wi; w2 *= wi * inv;
#pragma unroll
            for (int dt = 0; dt < 2; ++dt)
#pragma unroll
                for (int a = 0; a < 4; ++a) { const size_t off = tokq * 512 + h * 64 + dt * 32 + a * 8 + 4 * hi; const u32x2 a0 = *(const u32x2*)(O0 + off), a1 = *(const u32x2*)(O1 + off);
                    const float o0 = w0 * bf_lo(a0.x) + w1 * bf_lo(a1.x) + w2 * O[dt][4 * a], o1 = w0 * bf_hi(a0.x) + w1 * bf_hi(a1.x) + w2 * O[dt][4 * a + 1],
                                o2 = w0 * bf_lo(a0.y) + w1 * bf_lo(a1.y) + w2 * O[dt][4 * a + 2], o3 = w0 * bf_hi(a0.y) + w1 * bf_hi(a1.y) + w2 * O[dt][4 * a + 3];
                    u32x2 wv; wv.x = cvt_pk_bf16(o0, o1); wv.y = cvt_pk_bf16(o2, o3); *(u32x2*)(Og + off) = wv; }
        }
        __syncthreads();
    }
}


#define XB_TMO      128
#define XB_XCNT(j)  (256  + 64 * (j))
#define XB_XSUB(j)  (1280 + 64 * (j))
#define XB_XGEN(j)  (2304 + 64 * (j))
#define XB_TOP      3328
#define XB_TOPGEN   3392
#define XCD_BAR_WORDS 3456
#define XB_SPIN_CAP (1u << 28)

__device__ __forceinline__ unsigned xb_ld(unsigned* p)              { return __hip_atomic_load(p, __ATOMIC_RELAXED, __HIP_MEMORY_SCOPE_AGENT); }
__device__ __forceinline__ unsigned xb_add(unsigned* p, unsigned v) { return __hip_atomic_fetch_add(p, v, __ATOMIC_RELAXED, __HIP_MEMORY_SCOPE_AGENT); }
__device__ __forceinline__ unsigned xb_xcc_id() { return (unsigned)__builtin_amdgcn_s_getreg((3 << 11) | 20) & 0xFu; }
#define XB_SPIN(cond, bar) do { unsigned _sp = 0; while (cond) { __builtin_amdgcn_s_sleep(1); \
    if ((++_sp & 255u) == 0u) { if (xb_ld(&(bar)[XB_TMO])) break; if (_sp > XB_SPIN_CAP) { atomicAdd(&(bar)[XB_TMO], 1u); break; } } } } while (0)

struct XcdBarrier {
    unsigned* bar; unsigned x;
    volatile LAS unsigned* st;
};

__device__ __forceinline__ XcdBarrier xcd_barrier_post(unsigned* bar, volatile LAS unsigned* st) {
    XcdBarrier b; b.bar = bar; b.x = xb_xcc_id(); b.st = st;
    if (threadIdx.x == 0) (void)xb_add(&bar[XB_XCNT(b.x)], 1u);
    return b;
}
__device__ __forceinline__ void xcd_barrier_complete(unsigned* bar, unsigned x, unsigned& nloc, unsigned& nx) {
    const unsigned G = gridDim.x * gridDim.y * gridDim.z;
    unsigned sum, cnt, mine, sp = 0u;
    for (;;) {
        sum = 0u; cnt = 0u; mine = 0u;
#pragma unroll
        for (unsigned j = 0; j < 16; ++j) { const unsigned c = xb_ld(&bar[XB_XCNT(j)]); sum += c; cnt += (c > 0u) ? 1u : 0u; mine = (j == x) ? c : mine; }
        if (sum == G) break;
        __builtin_amdgcn_s_sleep(1);
        if ((++sp & 255u) == 0u) { if (xb_ld(&bar[XB_TMO])) break; if (sp > XB_SPIN_CAP) { atomicAdd(&bar[XB_TMO], 1u); break; } }
    }
    nloc = mine > 0u ? mine : 1u; nx = cnt > 0u ? cnt : 1u;
}

__device__ __forceinline__ void xcd_barrier(const XcdBarrier& b) {
    asm volatile("s_waitcnt vmcnt(0)" ::: "memory");
    __syncthreads();
    if (threadIdx.x == 0) {
        unsigned* bar = b.bar;
        __builtin_amdgcn_s_waitcnt(0);
        unsigned nloc = b.st[0], nx = b.st[1];
        if (nloc == 0u) { xcd_barrier_complete(bar, b.x, nloc, nx); b.st[0] = nloc; b.st[1] = nx; }
        const unsigned old = xb_add(&bar[XB_XSUB(b.x)], 1u);
        const unsigned gen = old / nloc;
        if (old + 1u == (gen + 1u) * nloc) {
            __builtin_amdgcn_fence(__ATOMIC_RELEASE, "agent");
            asm volatile("s_waitcnt vmcnt(0)" ::: "memory");
            const unsigned og = xb_add(&bar[XB_TOP], 1u);
            const unsigned tg = og / nx;
            if (og + 1u == (tg + 1u) * nx) xb_add(&bar[XB_TOPGEN], 1u);
            else XB_SPIN(xb_ld(&bar[XB_TOPGEN]) == tg, bar);
            __builtin_amdgcn_fence(__ATOMIC_ACQUIRE, "");
            xb_add(&bar[XB_XGEN(b.x)], 1u);
            asm volatile("s_waitcnt vmcnt(0)" ::: "memory");
        } else {
            XB_SPIN(xb_ld(&bar[XB_XGEN(b.x)]) == gen, bar);
            __builtin_amdgcn_fence(__ATOMIC_ACQUIRE, "agent");
            asm volatile("s_waitcnt vmcnt(0)" ::: "memory");
        }
    }
    __syncthreads();
}


__device__ __forceinline__ void dbg_dump(float* out, const bf16_t* src, int ncols) {
    const size_t n = (size_t)T * ncols; const size_t gt = (size_t)blockIdx.x * 512 + threadIdx.x, NT = (size_t)gridDim.x * 512;
    for (size_t i = gt; i < n; i += NT) { const size_t row = i / ncols, c = i - row * ncols; out[row * DM + c] = bf_lo((unsigned)src[i]); }
}
#ifndef DBG_STOP
#define DBG_STOP 0
#endif
#undef DIL_VLOAD
#define FRESH() CParams& P = *pp; unsigned char* ws = P.ws; bf16_t* XB = (bf16_t*)(ws + XB_OFF); bf16_t* H = (bf16_t*)(ws + R_H); (void)XB; (void)H; \
    float* SSQ1 = (float*)(ws + S_SSQ1); float* SSQ2 = (float*)(ws + S_SSQ2); float* SSQ3 = (float*)(ws + S_SSQ3); (void)SSQ1; (void)SSQ2; (void)SSQ3; \
    const float* mcos = (const float*)(ws + S_MCOS); const float* msin = (const float*)(ws + S_MSIN); const float* dcos = (const float*)(ws + S_DCOS); const float* dsin = (const float*)(ws + S_DSIN); (void)mcos; (void)msin; (void)dcos; (void)dsin;
#define GSYNC() do { XcdBarrier xb_; xb_.bar = (unsigned*)(pp->ws + S_CTL); xb_.x = xb_xcc_id(); xb_.st = (volatile LAS unsigned*)(lds + LDS_SCR + 8192); xcd_barrier(xb_); asm volatile("" : "+s"(pp) :: "memory"); } while (0)
__global__ void __launch_bounds__(512) mega_fwd(Params Pbyval) {
    extern __shared__ __attribute__((aligned(16))) unsigned char lds_raw[];
    LAS unsigned char* lds = (LAS unsigned char*)lds_raw;
    LAS float* scr = (LAS float*)(lds + LDS_SCR);
    cg::grid_group grid = cg::this_grid();
    CParams* pp = (CParams*)__builtin_amdgcn_kernarg_segment_ptr();
    asm volatile("" : "+s"(pp) :: "memory");
    volatile LAS unsigned* xst = (volatile LAS unsigned*)(lds + LDS_SCR + 8192);
    if (threadIdx.x < 2) xst[threadIdx.x] = 0u;
    __syncthreads();
    (void)xcd_barrier_post((unsigned*)(pp->ws + S_CTL), xst);
    grid.sync();

    { FRESH(); prologue(P, lds); }
#ifdef PROBE_PROL2
    GSYNC();
    { FRESH(); prologue(P, lds); }
#endif
    GSYNC();
    { FRESH(); EpiSwiglu e{(const float*)(ws + S_RS0), nullptr, H}; run_gemm(lds, XB, (const bf16_t*)(ws + W_GU1), T, 5632, 1024, e); }
#ifdef PROBE_G1X2
    GSYNC();
    { FRESH(); EpiSwiglu e{(const float*)(ws + S_RS0), nullptr, H}; run_gemm(lds, XB, (const bf16_t*)(ws + W_GU1), T, 5632, 1024, e); }
#endif
    GSYNC();
    { FRESH(); EpiResid<false> e{P.in[0], P.in[1], XB, SSQ1, 0.5f, scr}; run_gemm(lds, H, (const bf16_t*)(ws + W_D1), T, 1024, FF, e); }
    GSYNC();
    if (DBG_STOP == 1) return;
    if (DBG_STOP == 11) { { FRESH(); EpiDil e{SSQ1, P.in[16], P.in[17], dcos, dsin, (bf16_t*)(ws + R_DIL)}; run_gemm(lds, XB, (const bf16_t*)(ws + W_DIL), T, 1536, 1024, e); }
        GSYNC();
        { FRESH(); const size_t gt = (size_t)blockIdx.x * 512 + threadIdx.x, NT = (size_t)gridDim.x * 512; const bf16_t* G = (const bf16_t*)(ws + R_DIL);
          for (size_t i = gt; i < (size_t)T * 1024; i += NT) { const size_t row = i >> 10, c = i & 1023; P.out[i] = bf_lo((unsigned)G[row * 1536 + c]) + bf_lo((unsigned)G[row * 1536 + 512 + c]); } } return; }
    for (int g = 0; g < ((DBG_STOP == 9 || DBG_STOP == 12) ? 0 : 3); ++g) {
        { FRESH(); EpiDil e{SSQ1, P.in[16] + g * 64, P.in[17] + g * 64, dcos, dsin, (bf16_t*)(ws + R_DIL)}; run_gemm(lds, XB, (const bf16_t*)(ws + W_DIL) + (size_t)g * 1536 * 1024, T, 1536, 1024, e); }
        GSYNC();
        { FRESH(); dil_phase(lds, P, g); }
#ifdef PROBE_DIL2
        GSYNC();
        { FRESH(); dil_phase(lds, P, g); }
#endif
        GSYNC();
    }
    if (DBG_STOP == 2) { FRESH(); dbg_dump(P.out, (const bf16_t*)(ws + R_OD), 512); return; }
    for (int c = 0; c < ((DBG_STOP == 9 || DBG_STOP == 12) ? 0 : 2); ++c) {
        const int row0 = c * CH;
        { FRESH(); EpiA e{SSQ1, (bf16_t*)(ws + R_CQ), (bf16_t*)(ws + R_CKV), (float*)(ws + S_SSQQ), (float*)(ws + S_SSQKV), (float*)(ws + S_SSQPE), (float*)(ws + S_KPE), P.in[15], mcos, msin, row0, scr};
          run_gemm(lds, XB + (size_t)row0 * DM, (const bf16_t*)(ws + W_A), CH, 1024, 1024, e); }
        GSYNC();
        { FRESH(); EpiQ e{(const float*)(ws + S_SSQQ), P.in[14], mcos, msin, (bf16_t*)(ws + R_Q), scr, row0}; run_gemm(lds, (const bf16_t*)(ws + R_CQ), (const bf16_t*)(ws + W_UQ), CH, 2048, 512, e); }
        { FRESH(); EpiKV e{(const float*)(ws + S_SSQKV), (const float*)(ws + S_SSQPE), (const float*)(ws + S_KPE), P.in[15], (bf16_t*)(ws + R_K), (bf16_t*)(ws + R_V), scr, row0};
          run_gemm(lds, (const bf16_t*)(ws + R_CKV), (const bf16_t*)(ws + W_UKV), CH, 2048, 256, e); }
        GSYNC();
        { FRESH(); mla_phase(lds, P, c); }
#ifdef PROBE_MLA2
        GSYNC();
        { FRESH(); mla_phase(lds, P, c); }
#endif
        GSYNC();
    }
    if (DBG_STOP == 3) { FRESH(); dbg_dump(P.out, (const bf16_t*)(ws + R_OM), 1024); return; }
#ifdef PROBE_BAR10
    for (int i = 0; i < 10; ++i) GSYNC();
#endif
    if (DBG_STOP == 12) { FRESH(); EpiEW<5> e{SSQ1, nullptr, 0, (bf16_t*)(ws + R_GATES), 2048}; run_gemm(lds, XB, (const bf16_t*)(ws + W_G), T, 2048, 1024, e); } else
    { FRESH(); EpiEW<0> e{SSQ1, nullptr, 0, (bf16_t*)(ws + R_GATES), 2048}; run_gemm(lds, XB, (const bf16_t*)(ws + W_G), T, 2048, 1024, e); }
#ifdef PROBE_P9X2
    GSYNC();
    { FRESH(); EpiEW<0> e{SSQ1, nullptr, 0, (bf16_t*)(ws + R_GATES), 2048}; run_gemm(lds, XB, (const bf16_t*)(ws + W_G), T, 2048, 1024, e); }
#endif
    GSYNC();
    if (DBG_STOP == 8 || DBG_STOP == 9 || DBG_STOP == 12) { FRESH(); const size_t gt = (size_t)blockIdx.x * 512 + threadIdx.x, NT = (size_t)gridDim.x * 512; const bf16_t* G = (const bf16_t*)(ws + R_GATES);
        for (size_t i = gt; i < (size_t)T * 1024; i += NT) { const size_t row = i >> 10, c = i & 1023; P.out[i] = bf_lo((unsigned)G[row * 2048 + c]) + bf_lo((unsigned)G[row * 2048 + 1024 + c]); } return; }
    { FRESH(); EpiEW<1> e{nullptr, (const bf16_t*)(ws + R_GATES), 2048, (bf16_t*)(ws + R_TT), 1024}; run_gemm(lds, (const bf16_t*)(ws + R_OM), (const bf16_t*)(ws + W_OA), T, 1024, 1024, e); }
    GSYNC();
    if (DBG_STOP == 6) { FRESH(); dbg_dump(P.out, (const bf16_t*)(ws + R_TT), 1024); return; }
    { FRESH(); EpiEW<2> e{nullptr, (const bf16_t*)(ws + R_GATES) + 1024, 2048, (bf16_t*)(ws + R_TT), 1024}; run_gemm(lds, (const bf16_t*)(ws + R_OD), (const bf16_t*)(ws + W_OB), T, 1024, 512, e); }
    GSYNC();
    if (DBG_STOP == 7) { FRESH(); dbg_dump(P.out, (const bf16_t*)(ws + R_TT), 1024); return; }
    { FRESH(); EpiResid<true> e{nullptr, nullptr, XB, SSQ2, 1.0f, scr}; run_gemm(lds, (const bf16_t*)(ws + R_TT), (const bf16_t*)(ws + W_OUT), T, 1024, 1024, e); }
    GSYNC();
    if (DBG_STOP == 4) return;
    { FRESH(); bf16_t* PB = (bf16_t*)(ws + R_PB); const int gt = blockIdx.x * 512 + threadIdx.x, NT = gridDim.x * 512;
      for (int i = gt; i < T * 64; i += NT) { const int row = i >> 6, c4 = i & 63; const float* pr = row < TP ? P.in[2] + (size_t)row * 256 : P.in[3] + (size_t)(row - TP) * 256;
          const f32x4 v = ((const f32x4*)pr)[c4]; u32x2 w; w.x = cvt_pk_bf16(v[0], v[1]); w.y = cvt_pk_bf16(v[2], v[3]); ((u32x2*)(PB + (size_t)row * 256))[c4] = w; } }
    { FRESH(); EpiSwiglu e{nullptr, SSQ2, H}; run_gemm(lds, XB, (const bf16_t*)(ws + W_GU2), T, 5632, 1024, e); }
    GSYNC();
    { FRESH(); EpiResid<true> e{nullptr, nullptr, XB, SSQ3, 0.5f, scr}; run_gemm(lds, H, (const bf16_t*)(ws + W_D2), T, 1024, FF, e); }
    { FRESH(); EpiEW<3> e{nullptr, nullptr, 0, (bf16_t*)(ws + R_PEO), 1024}; run_gemm(lds, (const bf16_t*)(ws + R_PB), (const bf16_t*)(ws + W_PE), T, 1024, 256, e); }
    GSYNC();
    if (DBG_STOP == 5) return;
    { FRESH(); EpiFinal e{SSQ3, (const bf16_t*)(ws + R_PEO), XB, P.out}; run_gemm(lds, XB, (const bf16_t*)(ws + W_PG), T, 1024, 1024, e); }
}

extern "C" void kernel_launch(void* const* d_in, const int* in_sizes, int n_in, void* d_out, int out_size, void* d_ws, size_t ws_size, hipStream_t stream) {
    static int grid = 0;
    if (grid == 0) {
        if (n_in != 28 || out_size != T * DM || ws_size < WS_NEED) { fprintf(stderr, "kernel_launch: unexpected shapes (n_in %d out %d ws %zu)\n", n_in, out_size, ws_size); grid = -1; return; }
        int dev = 0, cus = 0, per_cu = 0;
        hipGetDevice(&dev); hipDeviceGetAttribute(&cus, hipDeviceAttributeMultiprocessorCount, dev);
        hipFuncSetAttribute((const void*)mega_fwd, hipFuncAttributeMaxDynamicSharedMemorySize, LDS_BYTES);
        hipOccupancyMaxActiveBlocksPerMultiprocessor(&per_cu, (const void*)mega_fwd, 512, LDS_BYTES);
        if (per_cu < 1) per_cu = 1;
        grid = cus * 1;
        (void)hipGetLastError();
    }
    if (grid < 0) return;
    Params p{};
    for (int i = 0; i < 28; ++i) p.in[i] = (const float*)d_in[i];
    p.out = (float*)d_out; p.ws = (unsigned char*)d_ws;
    hipMemsetAsync((char*)d_ws + S_CTL, 0, CTL_BYTES, stream);
    void* args[] = {&p};
    hipError_t e = hipLaunchCooperativeKernel((const void*)mega_fwd, dim3(grid), dim3(512), args, LDS_BYTES, stream);
    if (e != hipSuccess) fprintf(stderr, "cooperative launch failed: %s (grid %d)\n", hipGetErrorString(e), grid);
}
```

```cpp
#include <hip/hip_runtime.h>
#include <hip/hip_cooperative_groups.h>
#include <cstdio>
#include <cstdint>
namespace cg = cooperative_groups;
namespace pg8 {
#define PG8_LAS __attribute__((address_space(3)))
typedef unsigned short bf16_t;
typedef short bf16x8 __attribute__((ext_vector_type(8)));
typedef float f32x4 __attribute__((ext_vector_type(4)));
typedef unsigned u32x4 __attribute__((ext_vector_type(4)));
constexpr int BM = 256, BK = 64, HALF = 128, HTB = HALF * BK * 2  , STAGE_BYTES = 8 * HTB, NXCD = 8, WGM = 8;

__host__ __device__ __forceinline__ int lds_byte(int r, int c) { const int st = (r >> 4) * 2 + (c >> 5), rr = r & 15, cc = c & 31, ob = rr * 64 + cc * 2; return st * 1024 + (ob ^ (((ob >> 9) & 1) << 5)); }
__host__ __device__ __forceinline__ void stage_rc(int b, int& R, int& C) { const int st = b / 1024, sb = b % 1024, swz = sb ^ (((sb >> 9) & 1) << 5); R = (st >> 1) * 16 + swz / 64; C = (st & 1) * 32 + (swz % 64) / 2; }
__host__ __device__ __forceinline__ int perm32(int rho) { const int n = rho >> 4, i = rho & 15; return 8 * (i >> 2) + 4 * n + (i & 3); }

struct Unit { int pm, pn; };
struct Gemm { const bf16_t* A; const bf16_t* Bt; int M, N, K; };

struct StaticOrder {
    int nM, nN, nwg, G, c;
    __host__ __device__ void init(int M, int N, int G_, int c_) { nM = M / BM; nN = N / BM; nwg = nM * nN; G = G_; c = c_; }
    __host__ __device__ bool next(int i, Unit& u) const {
        const long L = (long)i * G + c; if (L >= nwg) return false;
        int wgid = (int)L; { const int q = nwg / NXCD, r = nwg % NXCD, xcd = wgid % NXCD, off = wgid / NXCD; wgid = (xcd < r ? xcd * (q + 1) : r * (q + 1) + (xcd - r) * q) + off; }
        const int nig = WGM * nN, gid = wgid / nig, fm = gid * WGM, gsz = (nM - fm) < WGM ? (nM - fm) : WGM;
        u.pm = fm + ((wgid % nig) % gsz); u.pn = (wgid % nig) / gsz; return true;
    }
    __device__ __forceinline__ void a_ready(const Unit&) const {}
    __device__ __forceinline__ void done(const Unit&) const {}
};
typedef float f32x2_cv __attribute__((ext_vector_type(2))); typedef __bf16 bf16x2_cv __attribute__((ext_vector_type(2)));
__device__ __forceinline__ unsigned cvt_pk_bf16(float lo, float hi) { f32x2_cv v = {lo, hi}; bf16x2_cv b = __builtin_convertvector(v, bf16x2_cv); return __builtin_bit_cast(unsigned, b); }
template <class Epi, class Sched, bool ALIGN_EPI = false, bool SP2 = false>
__device__ __forceinline__ void gemm_phase(PG8_LAS unsigned char* lds, const Gemm g, const Sched& S, const Epi& E) {
    int tid_ = threadIdx.x; asm volatile("" : "+v"(tid_));
    const int tid = tid_, wid = __builtin_amdgcn_readfirstlane(tid >> 6), lane = tid & 63, wr = wid >> 2, wc = wid & 3, fr = lane & 15, fq = lane >> 4;
    const int K = g.K, nt = K / BK;
    unsigned voffA[2], voffB[2];
#pragma unroll
    for (int i = 0; i < 2; ++i) { int R, C; stage_rc(tid * 16 + i * 8192, R, C); const int Rb = Epi::PERM ? ((R & ~31) + perm32(R & 31)) : R;
        voffA[i] = (unsigned)(R * K + C) * 2u; voffB[i] = (unsigned)(Rb * K + C) * 2u; }
    const size_t kstep = (size_t)(BK * 2);
    const size_t hstep = (size_t)HALF * K * 2;
    const size_t tstep = 2 * hstep;
    const unsigned ldsw = (unsigned)wid * 1024u; const unsigned ldsb0 = (unsigned)__builtin_amdgcn_readfirstlane((int)((unsigned)(uintptr_t)lds + ldsw));
    const int aoff = lds_byte(wr * 64 + fr, fq * 8), boff = lds_byte(wc * 32 + fr, fq * 8);
#define PG8_SA(b, h) (((b) * 2 + (h)) * HTB)
#define PG8_SB(b, h) ((4 + (b) * 2 + (h)) * HTB)
#define PG8_STAGE(bufoff, gbase, voff) do { _Pragma("unroll") for (int _i = 0; _i < 2; ++_i) \
        asm volatile("s_mov_b32 m0, %0\n\ts_nop 0\n\tglobal_load_lds_dwordx4 %1, %2" :: "s"(ldsb0 + (unsigned)((bufoff) + _i * 8192)), "v"((voff)[_i]), "s"((const char*)(gbase)) : "memory"); } while (0)
#define PG8_LDA(dst, b, h) do { _Pragma("unroll") for (int m = 0; m < 4; ++m) _Pragma("unroll") for (int k = 0; k < 2; ++k) dst[m][k] = *(const PG8_LAS bf16x8*)(lds + PG8_SA(b, h) + aoff + m * 2048 + k * 1024); } while (0)
#define PG8_LDB(dst, b, h) do { _Pragma("unroll") for (int n = 0; n < 2; ++n) _Pragma("unroll") for (int k = 0; k < 2; ++k) dst[n][k] = *(const PG8_LAS bf16x8*)(lds + PG8_SB(b, h) + boff + n * 2048 + k * 1024); } while (0)
#define PG8_MMA(ai, bj, At, Bt) do { __builtin_amdgcn_s_setprio(1); _Pragma("unroll") for (int m = 0; m < 4; ++m) _Pragma("unroll") for (int n = 0; n < 2; ++n) _Pragma("unroll") for (int k = 0; k < 2; ++k) \
        acc[ai][bj][m][n] = __builtin_amdgcn_mfma_f32_16x16x32_bf16(Bt[n][k], At[m][k], acc[ai][bj][m][n], 0, 0, 0); __builtin_amdgcn_s_setprio(0); } while (0)
#define PG8_WAIT_V(n) asm volatile("s_waitcnt vmcnt(" #n ")" ::: "memory")
#define PG8_WAIT_L(n) asm volatile("s_waitcnt lgkmcnt(" #n ")" ::: "memory")
#define PG8_BAR __builtin_amdgcn_s_barrier()
#define PG8_SCHED __builtin_amdgcn_sched_barrier(0)
    Unit cur, nxt; int ui = 0;
    if (!S.next(0, cur)) return;
    f32x4 acc[2][2][4][2];
#pragma unroll
    for (int a = 0; a < 2; ++a)
#pragma unroll
        for (int b = 0; b < 2; ++b)
#pragma unroll
            for (int m = 0; m < 4; ++m)
#pragma unroll
                for (int n = 0; n < 2; ++n) acc[a][b][m][n] = (f32x4){0.f, 0.f, 0.f, 0.f};
    bf16x8 At[4][2], B0[2][2], B1[2][2];
    const char* cA = (const char*)g.A + (size_t)cur.pm * tstep; const char* cB = (const char*)g.Bt + (size_t)cur.pn * tstep;
    S.a_ready(cur);
    if constexpr (SP2) {
        PG8_STAGE(PG8_SB(0, 0), cB, voffB); PG8_STAGE(PG8_SB(0, 1), cB + hstep, voffB); PG8_STAGE(PG8_SA(0, 0), cA, voffA); PG8_STAGE(PG8_SA(0, 1), cA + hstep, voffA);
        if (wr == 1) PG8_BAR;
        PG8_WAIT_V(2); PG8_BAR;
        PG8_STAGE(PG8_SB(1, 0), cB + kstep, voffB); PG8_STAGE(PG8_SA(1, 0), cA + kstep, voffA); PG8_STAGE(PG8_SB(1, 1), cB + hstep + kstep, voffB);
        PG8_WAIT_V(6); PG8_BAR;
    } else {
        PG8_STAGE(PG8_SB(0, 0), cB, voffB); PG8_STAGE(PG8_SA(0, 0), cA, voffA); PG8_STAGE(PG8_SB(0, 1), cB + hstep, voffB); PG8_STAGE(PG8_SA(0, 1), cA + hstep, voffA);
        if (wr == 1) PG8_BAR;
        PG8_WAIT_V(4); PG8_BAR;
        PG8_STAGE(PG8_SB(1, 0), cB + kstep, voffB); PG8_STAGE(PG8_SA(1, 0), cA + kstep, voffA); PG8_STAGE(PG8_SB(1, 1), cB + hstep + kstep, voffB);
        PG8_WAIT_V(6); PG8_BAR;
    }
    for (;;) {
        const bool has_next = S.next(ui + 1, nxt);
        const char* nA = has_next ? (const char*)g.A + (size_t)nxt.pm * tstep : cA; const char* nB = has_next ? (const char*)g.Bt + (size_t)nxt.pn * tstep : cB;
        for (int t = 0; t < nt; t += 2) {
            const bool last = (t == nt - 2);
            const char* a1 = cA + (size_t)(t + 1) * kstep;
            const char* a2 = last ? nA : cA + (size_t)(t + 2) * kstep; const char* b2 = last ? nB : cB + (size_t)(t + 2) * kstep;
            const char* a3 = a2 + kstep; const char* b3 = b2 + kstep;
            if (last && has_next) S.a_ready(nxt);
            if constexpr (SP2) {
            PG8_LDB(B0, 0, 0); PG8_LDB(B1, 0, 1); PG8_SCHED; PG8_LDA(At, 0, 0); PG8_STAGE(PG8_SA(1, 1), a1 + hstep, voffA);
            PG8_WAIT_V(8); PG8_WAIT_L(0); PG8_BAR; PG8_MMA(0, 0, At, B0); PG8_MMA(0, 1, At, B1); PG8_BAR; PG8_SCHED;
            PG8_LDA(At, 0, 1); PG8_STAGE(PG8_SB(0, 0), b2, voffB); PG8_STAGE(PG8_SB(0, 1), b2 + hstep, voffB); PG8_STAGE(PG8_SA(0, 0), a2, voffA);
            PG8_WAIT_V(8); PG8_WAIT_L(0); PG8_BAR; PG8_MMA(1, 0, At, B0); PG8_MMA(1, 1, At, B1); PG8_BAR; PG8_SCHED;
            PG8_LDB(B0, 1, 0); PG8_LDB(B1, 1, 1); PG8_SCHED; PG8_LDA(At, 1, 0); PG8_STAGE(PG8_SA(0, 1), a2 + hstep, voffA);
            PG8_WAIT_V(8); PG8_WAIT_L(0); PG8_BAR; PG8_MMA(0, 0, At, B0); PG8_MMA(0, 1, At, B1); PG8_BAR; PG8_SCHED;
            PG8_LDA(At, 1, 1); PG8_STAGE(PG8_SB(1, 0), b3, voffB); PG8_STAGE(PG8_SB(1, 1), b3 + hstep, voffB); PG8_STAGE(PG8_SA(1, 0), a3, voffA);
            PG8_WAIT_V(8); PG8_WAIT_L(0); PG8_BAR; PG8_MMA(1, 0, At, B0); PG8_MMA(1, 1, At, B1); PG8_BAR; PG8_SCHED;
            } else {
            PG8_LDB(B0, 0, 0); PG8_SCHED; PG8_LDA(At, 0, 0); PG8_STAGE(PG8_SA(1, 1), a1 + hstep, voffA);
            PG8_WAIT_L(8); PG8_BAR; PG8_WAIT_L(0); PG8_MMA(0, 0, At, B0); PG8_BAR; PG8_SCHED;
            PG8_LDB(B1, 0, 1); PG8_STAGE(PG8_SB(0, 0), b2, voffB);
            PG8_BAR; PG8_WAIT_L(0); PG8_MMA(0, 1, At, B1); PG8_BAR;
            PG8_LDA(At, 0, 1); PG8_STAGE(PG8_SA(0, 0), a2, voffA);
            PG8_BAR; PG8_WAIT_L(0); PG8_MMA(1, 0, At, B0); PG8_BAR; PG8_SCHED;
            PG8_STAGE(PG8_SB(0, 1), b2 + hstep, voffB);
            PG8_WAIT_V(6); PG8_BAR; PG8_MMA(1, 1, At, B1); PG8_BAR;
            PG8_LDB(B0, 1, 0); PG8_SCHED; PG8_LDA(At, 1, 0); PG8_STAGE(PG8_SA(0, 1), a2 + hstep, voffA);
            PG8_WAIT_L(8); PG8_BAR; PG8_WAIT_L(0); PG8_MMA(0, 0, At, B0); PG8_BAR; PG8_SCHED;
            PG8_LDB(B1, 1, 1); PG8_STAGE(PG8_SB(1, 0), b3, voffB);
            PG8_BAR; PG8_WAIT_L(0); PG8_MMA(0, 1, At, B1); PG8_BAR;
            PG8_LDA(At, 1, 1); PG8_STAGE(PG8_SA(1, 0), a3, voffA);
            PG8_BAR; PG8_WAIT_L(0); PG8_MMA(1, 0, At, B0); PG8_BAR; PG8_SCHED;
            PG8_STAGE(PG8_SB(1, 1), b3 + hstep, voffB);
            PG8_WAIT_V(6); PG8_BAR; PG8_MMA(1, 1, At, B1); PG8_BAR;
            }
        }
        if constexpr (ALIGN_EPI) { if (wr == 0) PG8_BAR; }
        if constexpr (!Epi::AFTER_DRAIN) { E(acc, cur, wr, wc, fr, fq); S.done(cur); }
        if (!has_next) break;
#pragma unroll
        for (int a = 0; a < 2; ++a)
#pragma unroll
            for (int b = 0; b < 2; ++b)
#pragma unroll
                for (int m = 0; m < 4; ++m)
#pragma unroll
                    for (int n = 0; n < 2; ++n) acc[a][b][m][n] = (f32x4){0.f, 0.f, 0.f, 0.f};
        cur = nxt; cA = nA; cB = nB; ++ui;
        if constexpr (ALIGN_EPI) { if (wr == 1) PG8_BAR; }
    }
    PG8_WAIT_V(0);
    if constexpr (!ALIGN_EPI) { if (wr == 0) PG8_BAR; }
    PG8_BAR;
    if constexpr (Epi::AFTER_DRAIN) { E.fused(acc, cur, wr, wc, fr, fq, lds, wid, lane); S.done(cur); }
#undef PG8_SA
#undef PG8_SB
#undef PG8_STAGE
#undef PG8_LDA
#undef PG8_LDB
#undef PG8_MMA
#undef PG8_WAIT_V
#undef PG8_WAIT_L
#undef PG8_BAR
#undef PG8_SCHED
}
}

#define LAS __attribute__((address_space(3)))
using pg8::bf16_t; using pg8::bf16x8; using pg8::f32x4; using pg8::u32x4; using pg8::Unit; using pg8::cvt_pk_bf16;
typedef float f32x16 __attribute__((ext_vector_type(16)));
typedef short v4i16_t __attribute__((ext_vector_type(4)));
typedef unsigned u32x2 __attribute__((ext_vector_type(2)));

constexpr int T = 81920, TP = 16384, SS = 2048, DM = 1024, FF = 2816, CH = 40960;
constexpr float EPS = 1e-6f, LOG2E = 1.4426950408889634f;
constexpr size_t MiB = 1u << 20;
constexpr size_t W_GU1 = 0, W_D1 = W_GU1 + 5632ull * 1024 * 2, W_GU2 = W_D1 + 1024ull * 2816 * 2, W_D2 = W_GU2 + 5632ull * 1024 * 2,
                 W_DIL = W_D2 + 1024ull * 2816 * 2, W_A = W_DIL + 4608ull * 1024 * 2, W_UQ = W_A + 1024ull * 1024 * 2, W_UKV = W_UQ + 2048ull * 512 * 2,
                 W_G = W_UKV + 2048ull * 256 * 2, W_OA = W_G + 2048ull * 1024 * 2, W_OB = W_OA + 1024ull * 1024 * 2, W_OUT = W_OB + 1024ull * 512 * 2,
                 W_PG = W_OUT + 1024ull * 1024 * 2, W_PE = W_PG + 1024ull * 1024 * 2, W_END = W_PE + 1024ull * 256 * 2;
static_assert(W_END <= 64 * MiB, "weights");
constexpr size_t S_BASE = 64 * MiB;
constexpr size_t S_RS0 = S_BASE, S_SSQ1 = S_RS0 + (size_t)T * 4, S_SSQ2 = S_SSQ1 + (size_t)T * 64, S_SSQ3 = S_SSQ2 + (size_t)T * 64,
                 S_SSQQ = S_SSQ3 + (size_t)T * 64, S_SSQKV = S_SSQQ + (size_t)T * 32, S_SSQPE = S_SSQKV + (size_t)T * 16, S_KPE = S_SSQPE + (size_t)T * 4,
                 S_L0 = S_KPE + (size_t)T * 256, S_L1 = S_L0 + (size_t)T * 32, S_MCOS = S_L1 + (size_t)T * 32, S_MSIN = S_MCOS + 16384ull * 32 * 4,
                 S_DCOS = S_MSIN + 16384ull * 32 * 4, S_DSIN = S_DCOS + 16384ull * 8 * 4, S_END = S_DSIN + 16384ull * 8 * 4;
constexpr size_t S_CTL = (S_END + 4095) / 4096 * 4096, CTL_BYTES = 16384;
static_assert(S_CTL + CTL_BYTES <= 128 * MiB, "small");
constexpr size_t XB_OFF = 128 * MiB;
constexpr size_t R = 288 * MiB;
constexpr size_t R_H = R, R_DIL = R, R_O0 = R + 240 * MiB, R_O1 = R + 320 * MiB, R_OD = R + 656 * MiB;
constexpr size_t R_Q = R, R_K = R + 120 * MiB, R_V = R + 240 * MiB, R_OM = R + 320 * MiB, R_CQ = R + 480 * MiB, R_CKV = R + 520 * MiB;
constexpr size_t R_GATES = R, R_TT = R + 480 * MiB, R_PB = R + 440 * MiB, R_PEO = R + 480 * MiB;
constexpr size_t WS_NEED = 1024 * MiB;

constexpr int LDS_BYTES = 147456, LDS_SCR = 131072;

struct Params { const float* in[28]; float* out; unsigned char* ws; };
typedef const __attribute__((address_space(4))) Params CParams;
__device__ __forceinline__ const void* uniform_ptr(const void* p) { const unsigned long long v = (unsigned long long)p; const unsigned lo = __builtin_amdgcn_readfirstlane((unsigned)v), hi = __builtin_amdgcn_readfirstlane((unsigned)(v >> 32)); return (const void*)(((unsigned long long)hi << 32) | lo); }

__device__ __forceinline__ int tok_pos(int row) { return row < TP ? row : (row & (SS - 1)); }
__device__ __forceinline__ float fsigmoid(float x) { return __builtin_amdgcn_rcpf(1.f + __builtin_amdgcn_exp2f(-x * LOG2E)); }
__device__ __forceinline__ float rs16(const float* ssq, int row) {
    const float a = __hip_atomic_load(ssq + row, __ATOMIC_RELAXED, __HIP_MEMORY_SCOPE_AGENT), b = __hip_atomic_load(ssq + T + row, __ATOMIC_RELAXED, __HIP_MEMORY_SCOPE_AGENT),
                c = __hip_atomic_load(ssq + 2 * T + row, __ATOMIC_RELAXED, __HIP_MEMORY_SCOPE_AGENT), d = __hip_atomic_load(ssq + 3 * T + row, __ATOMIC_RELAXED, __HIP_MEMORY_SCOPE_AGENT);
    return rsqrtf(((a + b) + (c + d)) * (1.f / 1024.f) + EPS);
}
__device__ __forceinline__ u32x4 pack8(f32x4 a, f32x4 b) { u32x4 w; w.x = cvt_pk_bf16(a[0], a[1]); w.y = cvt_pk_bf16(a[2], a[3]); w.z = cvt_pk_bf16(b[0], b[1]); w.w = cvt_pk_bf16(b[2], b[3]); return w; }
__device__ __forceinline__ float bf_lo(unsigned w) { return __builtin_bit_cast(float, w << 16); }
__device__ __forceinline__ float bf_hi(unsigned w) { return __builtin_bit_cast(float, w & 0xffff0000u); }
__device__ __forceinline__ float dot4(f32x4 v) { return (v[0] * v[0] + v[1] * v[1]) + (v[2] * v[2] + v[3] * v[3]); }
__device__ __forceinline__ float quad_sum(float s) { s += __shfl_xor(s, 16); s += __shfl_xor(s, 32); return s; }

#define EPI_ROWS(ai, m) (u.pm * 256 + (ai) * 128 + wr * 64 + (m) * 16 + fr)
typedef f32x4 (&AccRef)[2][2][4][2];

struct EpiSwiglu {
    static constexpr bool PERM = true, AFTER_DRAIN = false;
    const float* rs_direct; const float* ssq16; bf16_t* H;
    __device__ __forceinline__ void operator()(AccRef acc, const Unit& u, int wr, int wc, int fr, int fq) const {
        asm volatile("" : "+v"(fr), "+v"(fq));
#pragma unroll
        for (int ai = 0; ai < 2; ++ai)
#pragma unroll
            for (int m = 0; m < 4; ++m) { asm volatile("" ::: "memory");
                const int row = EPI_ROWS(ai, m); const float rs = rs_direct ? rs_direct[row] : rs16(ssq16, row);
                f32x4 h[2];
                const float nrl = -rs * LOG2E, rs2 = rs * rs;
#pragma unroll
                for (int n = 0; n < 2; ++n) { const f32x4 g = acc[ai][0][m][n], up = acc[ai][1][m][n];
#pragma unroll
                    for (int e = 0; e < 4; ++e) h[n][e] = (g[e] * up[e]) * (rs2 * __builtin_amdgcn_rcpf(1.f + __builtin_amdgcn_exp2f(g[e] * nrl))); }
                *(u32x4*)(H + (size_t)row * FF + u.pn * 128 + wc * 32 + fq * 8) = pack8(h[0], h[1]);
            }
    }
};
template <bool RESBF> struct EpiResid {
    static constexpr bool PERM = true, AFTER_DRAIN = false;
    const float* resA; const float* resB; bf16_t* xb; float* ssq; float scale; LAS float* scr;
    __device__ __forceinline__ void operator()(AccRef acc, const Unit& u, int wr, int wc, int fr, int fq) const {
        asm volatile("" : "+v"(fr), "+v"(fq));
#pragma unroll
        for (int ai = 0; ai < 2; ++ai)
#pragma unroll
            for (int m = 0; m < 4; ++m) { asm volatile("" ::: "memory");
                const int row = EPI_ROWS(ai, m); const float* rp = row < TP ? resA + (size_t)row * DM : resB + (size_t)(row - TP) * DM;
                float part = 0.f;
#pragma unroll
                for (int bj = 0; bj < 2; ++bj) { const int col0 = u.pn * 256 + bj * 128 + wc * 32 + fq * 8; f32x4 v[2];
                    if (RESBF) { const u32x4 p = *(const u32x4*)(xb + (size_t)row * DM + col0);
                        v[0] = (f32x4){bf_lo(p.x), bf_hi(p.x), bf_lo(p.y), bf_hi(p.y)} + acc[ai][bj][m][0] * scale; v[1] = (f32x4){bf_lo(p.z), bf_hi(p.z), bf_lo(p.w), bf_hi(p.w)} + acc[ai][bj][m][1] * scale;
                    } else {
#pragma unroll
                        for (int n = 0; n < 2; ++n) v[n] = *(const f32x4*)(rp + col0 + 4 * n) + acc[ai][bj][m][n] * scale; }
                    part += dot4(v[0]) + dot4(v[1]);
                    *(u32x4*)(xb + (size_t)row * DM + col0) = pack8(v[0], v[1]); }
                part = quad_sum(part);
                if (fq == 0) scr[(ai * 128 + wr * 64 + m * 16 + fr) * 4 + wc] = part;
            }
        asm volatile("s_waitcnt lgkmcnt(0)" ::: "memory"); __builtin_amdgcn_s_barrier(); asm volatile("" ::: "memory");
        if (wc == 0 && fq == 0) {
#pragma unroll
            for (int ai = 0; ai < 2; ++ai)
#pragma unroll
                for (int m = 0; m < 4; ++m) { const f32x4 pp = *(const LAS f32x4*)(scr + (ai * 128 + wr * 64 + m * 16 + fr) * 4);
                    ssq[(size_t)u.pn * T + EPI_ROWS(ai, m)] = (pp[0] + pp[1]) + (pp[2] + pp[3]); }
        }
    }
};
struct EpiDil {
    static constexpr bool PERM = true, AFTER_DRAIN = false;
    const float* ssq16; const float* gq; const float* gk; const float* dcos; const float* dsin; bf16_t* out;
    __device__ __forceinline__ void operator()(AccRef acc, const Unit& u, int wr, int wc, int fr, int fq) const {
        asm volatile("" : "+v"(fr), "+v"(fq));
        const int s = u.pn >> 1, h = (u.pn & 1) * 4 + wc;
        f32x4 g4[2][2];
        if (s < 2) { const float* gp = s == 0 ? gq : gk;
#pragma unroll
            for (int bj = 0; bj < 2; ++bj)
#pragma unroll
                for (int n = 0; n < 2; ++n) { const int d0 = (bj == 0 && fq < 2) ? 4 * fq + 8 * n : bj * 32 + 8 * fq + 4 * n; g4[bj][n] = *(const f32x4*)(gp + d0); } }
#pragma unroll
        for (int ai = 0; ai < 2; ++ai)
#pragma unroll
            for (int m = 0; m < 4; ++m) { asm volatile("" ::: "memory");
                const int row = EPI_ROWS(ai, m); const float rs = rs16(ssq16, row);
                f32x4 v[2][2]; float part = 0.f;
#pragma unroll
                for (int bj = 0; bj < 2; ++bj)
#pragma unroll
                    for (int n = 0; n < 2; ++n) { v[bj][n] = acc[ai][bj][m][n] * rs; part += dot4(v[bj][n]); }
                if (s < 2) {
                    part = quad_sum(part);
                    float rn = rsqrtf(part * (1.f / 64.f) + EPS); if (s == 0) rn *= 0.125f * LOG2E;
#pragma unroll
                    for (int bj = 0; bj < 2; ++bj)
#pragma unroll
                        for (int n = 0; n < 2; ++n) v[bj][n] = v[bj][n] * rn * g4[bj][n];
                    if (fq < 2) { const int pos = tok_pos(row); const f32x4 c = *(const f32x4*)(dcos + pos * 8 + 4 * fq), sn = *(const f32x4*)(dsin + pos * 8 + 4 * fq);
                        const f32x4 x1 = v[0][0], x2 = v[0][1]; v[0][0] = x1 * c - x2 * sn; v[0][1] = x2 * c + x1 * sn; }
                }
                bf16_t* o = out + (size_t)row * 1536 + s * 512 + h * 64 + fq * 8;
                *(u32x4*)(o) = pack8(v[0][0], v[0][1]); *(u32x4*)(o + 32) = pack8(v[1][0], v[1][1]);
            }
    }
};
struct EpiA {
    static constexpr bool PERM = true, AFTER_DRAIN = false;
    const float* ssq16; bf16_t* CQ; bf16_t* CKV; float* SSQQ; float* SSQKV; float* SSQPE; float* KPE; const float* gk; const float* mcos; const float* msin; int row0; LAS float* scr;
    __device__ __forceinline__ void operator()(AccRef acc, const Unit& u, int wr, int wc, int fr, int fq) const {
        asm volatile("" : "+v"(fr), "+v"(fq));
        const int pn = u.pn;
        if (!(pn == 3 && wc != 0)) {
#pragma unroll
        for (int ai = 0; ai < 2; ++ai)
#pragma unroll
            for (int m = 0; m < 4; ++m) { asm volatile("" ::: "memory");
                const int lrow = EPI_ROWS(ai, m), grow = row0 + lrow; const float rs = rs16(ssq16, grow);
                f32x4 v[2][2]; float part = 0.f;
#pragma unroll
                for (int bj = 0; bj < 2; ++bj)
#pragma unroll
                    for (int n = 0; n < 2; ++n) { v[bj][n] = acc[ai][bj][m][n] * rs; part += dot4(v[bj][n]); }
                part = quad_sum(part);
                if (pn < 2) {
                    bf16_t* o = CQ + (size_t)lrow * 512 + pn * 256 + wc * 32 + fq * 8;
                    *(u32x4*)o = pack8(v[0][0], v[0][1]); *(u32x4*)(o + 128) = pack8(v[1][0], v[1][1]);
                } else if (pn == 2) {
                    bf16_t* o = CKV + (size_t)lrow * 256 + wc * 32 + fq * 8;
                    *(u32x4*)o = pack8(v[0][0], v[0][1]); *(u32x4*)(o + 128) = pack8(v[1][0], v[1][1]);
                } else {
                    if (fq == 0) SSQPE[grow] = part;
                    const int pos = tok_pos(grow);
#pragma unroll
                    for (int n = 0; n < 2; ++n) { const int i0 = 8 * fq + 4 * n;
                        const f32x4 a = v[0][n] * *(const f32x4*)(gk + 128 + i0), b = v[1][n] * *(const f32x4*)(gk + 160 + i0);
                        const f32x4 c = *(const f32x4*)(mcos + pos * 32 + i0), sn = *(const f32x4*)(msin + pos * 32 + i0);
                        *(f32x4*)(KPE + (size_t)grow * 64 + i0) = a * c - b * sn; *(f32x4*)(KPE + (size_t)grow * 64 + 32 + i0) = b * c + a * sn; }
                }
                if (fq == 0) scr[(ai * 128 + wr * 64 + m * 16 + fr) * 4 + wc] = part;
            }
        }
        asm volatile("s_waitcnt lgkmcnt(0)" ::: "memory"); __builtin_amdgcn_s_barrier(); asm volatile("" ::: "memory");
        if (pn < 3 && wc == 0 && fq == 0) {
#pragma unroll
            for (int ai = 0; ai < 2; ++ai)
#pragma unroll
                for (int m = 0; m < 4; ++m) { const f32x4 pp = *(const LAS f32x4*)(scr + (ai * 128 + wr * 64 + m * 16 + fr) * 4); const float tot = (pp[0] + pp[1]) + (pp[2] + pp[3]);
                    const int grow = row0 + EPI_ROWS(ai, m);
                    if (pn < 2) SSQQ[(size_t)pn * T + grow] = tot; else SSQKV[grow] = tot; }
        }
    }
};
struct EpiQ {
    static constexpr bool PERM = true, AFTER_DRAIN = false;
    const float* SSQQ; const float* gq; const float* mcos; const float* msin; bf16_t* Q; LAS float* scr; int row0;
    __device__ __forceinline__ void operator()(AccRef acc, const Unit& u, int wr, int wc, int fr, int fq) const {
        asm volatile("" : "+v"(fr), "+v"(fq));
        const int h = u.pn;
#pragma unroll
        for (int ai = 0; ai < 2; ++ai)
#pragma unroll
            for (int m = 0; m < 4; ++m) { asm volatile("" ::: "memory");
                const int grow = row0 + EPI_ROWS(ai, m);
                const float rq = rsqrtf((SSQQ[grow] + SSQQ[T + grow]) * (1.f / 512.f) + EPS);
                float part = 0.f;
#pragma unroll
                for (int bj = 0; bj < 2; ++bj)
#pragma unroll
                    for (int n = 0; n < 2; ++n) { acc[ai][bj][m][n] = acc[ai][bj][m][n] * rq; part += dot4(acc[ai][bj][m][n]); }
                part = quad_sum(part);
                if (fq == 0) scr[(ai * 128 + wr * 64 + m * 16 + fr) * 4 + wc] = part;
            }
        asm volatile("s_waitcnt lgkmcnt(0)" ::: "memory"); __builtin_amdgcn_s_barrier(); asm volatile("" ::: "memory");
        if (wc == 3) return;
        f32x4 g4[2][2];
#pragma unroll
        for (int bj = 0; bj < 2; ++bj)
#pragma unroll
            for (int n = 0; n < 2; ++n) g4[bj][n] = *(const f32x4*)(gq + wc * 64 + bj * 32 + 8 * fq + 4 * n);
#pragma unroll
        for (int ai = 0; ai < 2; ++ai)
#pragma unroll
            for (int m = 0; m < 4; ++m) { asm volatile("" ::: "memory");
                const int lrow = EPI_ROWS(ai, m), grow = row0 + lrow;
                const f32x4 pp = *(const LAS f32x4*)(scr + (ai * 128 + wr * 64 + m * 16 + fr) * 4);
                const float rn = rsqrtf(((pp[0] + pp[1]) + pp[2]) * (1.f / 192.f) + EPS) * (0.07216878364870322f * LOG2E);
                f32x4 v[2][2];
#pragma unroll
                for (int bj = 0; bj < 2; ++bj)
#pragma unroll
                    for (int n = 0; n < 2; ++n) v[bj][n] = acc[ai][bj][m][n] * rn * g4[bj][n];
                if (wc == 2) { const int pos = tok_pos(grow);
#pragma unroll
                    for (int n = 0; n < 2; ++n) { const int i0 = 8 * fq + 4 * n; const f32x4 c = *(const f32x4*)(mcos + pos * 32 + i0), sn = *(const f32x4*)(msin + pos * 32 + i0);
                        const f32x4 a = v[0][n], b = v[1][n]; v[0][n] = a * c - b * sn; v[1][n] = b * c + a * sn; } }
                bf16_t* o = Q + (size_t)lrow * 1536 + h * 192 + wc * 64 + fq * 8;
                *(u32x4*)o = pack8(v[0][0], v[0][1]); *(u32x4*)(o + 32) = pack8(v[1][0], v[1][1]);
            }
    }
};
struct EpiKV {
    static constexpr bool PERM = true, AFTER_DRAIN = false;
    const float* SSQKV; const float* SSQPE; const float* KPE; const float* gk; bf16_t* K; bf16_t* V; LAS float* scr; int row0;
    __device__ __forceinline__ void operator()(AccRef acc, const Unit& u, int wr, int wc, int fr, int fq) const {
        asm volatile("" : "+v"(fr), "+v"(fq));
        const int h = u.pn;
#pragma unroll
        for (int ai = 0; ai < 2; ++ai)
#pragma unroll
            for (int m = 0; m < 4; ++m) { asm volatile("" ::: "memory");
                const int grow = row0 + EPI_ROWS(ai, m);
                const float rkv = rsqrtf(SSQKV[grow] * (1.f / 256.f) + EPS);
                float part = 0.f;
#pragma unroll
                for (int bj = 0; bj < 2; ++bj)
#pragma unroll
                    for (int n = 0; n < 2; ++n) { acc[ai][bj][m][n] = acc[ai][bj][m][n] * rkv; part += dot4(acc[ai][bj][m][n]); }
                part = quad_sum(part);
                if (fq == 0 && wc < 2) scr[(ai * 128 + wr * 64 + m * 16 + fr) * 2 + wc] = part;
            }
        asm volatile("s_waitcnt lgkmcnt(0)" ::: "memory"); __builtin_amdgcn_s_barrier(); asm volatile("" ::: "memory");
        float rn[2][4];
#pragma unroll
        for (int ai = 0; ai < 2; ++ai)
#pragma unroll
            for (int m = 0; m < 4; ++m) { const int grow = row0 + EPI_ROWS(ai, m); const int rl = ai * 128 + wr * 64 + m * 16 + fr;
                rn[ai][m] = rsqrtf((scr[rl * 2] + scr[rl * 2 + 1] + SSQPE[grow]) * (1.f / 192.f) + EPS); }
        if (wc < 2) {
#pragma unroll
            for (int bj = 0; bj < 2; ++bj) {
                const f32x4 g0 = *(const f32x4*)(gk + wc * 64 + bj * 32 + 8 * fq), g1 = *(const f32x4*)(gk + wc * 64 + bj * 32 + 8 * fq + 4);
#pragma unroll
                for (int ai = 0; ai < 2; ++ai)
#pragma unroll
                    for (int m = 0; m < 4; ++m) { const int lrow = EPI_ROWS(ai, m);
                        *(u32x4*)(K + (size_t)lrow * 1536 + h * 192 + wc * 64 + bj * 32 + fq * 8) = pack8(acc[ai][bj][m][0] * rn[ai][m] * g0, acc[ai][bj][m][1] * rn[ai][m] * g1); }
                asm volatile("" ::: "memory");
            }
        } else {
#pragma unroll
            for (int ai = 0; ai < 2; ++ai)
#pragma unroll
                for (int m = 0; m < 4; ++m) { asm volatile("" ::: "memory");
                    const int lrow = EPI_ROWS(ai, m), grow = row0 + lrow;
                    bf16_t* o = V + (size_t)lrow * 1024 + h * 128 + (wc - 2) * 64 + fq * 8;
                    *(u32x4*)o = pack8(acc[ai][0][m][0], acc[ai][0][m][1]); *(u32x4*)(o + 32) = pack8(acc[ai][1][m][0], acc[ai][1][m][1]);
                    const int j0 = (wc - 2) * 32 + fq * 8; const f32x4 k0 = *(const f32x4*)(KPE + (size_t)grow * 64 + j0), k1 = *(const f32x4*)(KPE + (size_t)grow * 64 + j0 + 4);
                    *(u32x4*)(K + (size_t)lrow * 1536 + h * 192 + 128 + j0) = pack8(k0 * rn[ai][m], k1 * rn[ai][m]); }
        }
    }
};
template <int MODE> struct EpiEW {
    static constexpr bool PERM = true, AFTER_DRAIN = false;
    const float* ssq16; const bf16_t* aux; int ldaux; bf16_t* out; int ldo;
    __device__ __forceinline__ void operator()(AccRef acc, const Unit& u, int wr, int wc, int fr, int fq) const {
        asm volatile("" : "+v"(fr), "+v"(fq));
#pragma unroll
        for (int ai = 0; ai < 2; ++ai)
#pragma unroll
            for (int m = 0; m < 4; ++m) { asm volatile("" ::: "memory");
                const int row = EPI_ROWS(ai, m); float rs = 1.f; if (MODE == 0 || MODE == 5) rs = rs16(ssq16, row);
#pragma unroll
                for (int bj = 0; bj < 2; ++bj) { const int col0 = u.pn * 256 + bj * 128 + wc * 32 + fq * 8; f32x4 v[2] = {acc[ai][bj][m][0], acc[ai][bj][m][1]};
                    if (MODE == 0 || MODE == 4) {
#pragma unroll
                        for (int n = 0; n < 2; ++n)
#pragma unroll
                            for (int e = 0; e < 4; ++e) v[n][e] = __builtin_amdgcn_rcpf(1.f + __builtin_amdgcn_exp2f(v[n][e] * (-rs * LOG2E)));
                    } else if (MODE == 5) { v[0] = v[0] * rs; v[1] = v[1] * rs;
                    } else if (MODE == 1 || MODE == 2) {
                        const u32x4 g = *(const u32x4*)(aux + (size_t)row * ldaux + col0);
                        const f32x4 ga = {bf_lo(g.x), bf_hi(g.x), bf_lo(g.y), bf_hi(g.y)}, gb = {bf_lo(g.z), bf_hi(g.z), bf_lo(g.w), bf_hi(g.w)};
                        v[0] = v[0] * ga; v[1] = v[1] * gb;
                        if (MODE == 2) { const u32x4 p = *(const u32x4*)(out + (size_t)row * ldo + col0);
                            v[0] = v[0] + (f32x4){bf_lo(p.x), bf_hi(p.x), bf_lo(p.y), bf_hi(p.y)}; v[1] = v[1] + (f32x4){bf_lo(p.z), bf_hi(p.z), bf_lo(p.w), bf_hi(p.w)}; }
                    }
                    *(u32x4*)(out + (size_t)row * ldo + col0) = pack8(v[0], v[1]); }
            }
    }
};
struct EpiFinal {
    static constexpr bool PERM = true, AFTER_DRAIN = false;
    const float* ssq16; const bf16_t* pe; const bf16_t* xb; float* out;
    __device__ __forceinline__ void operator()(AccRef acc, const Unit& u, int wr, int wc, int fr, int fq) const {
        asm volatile("" : "+v"(fr), "+v"(fq));
#pragma unroll
        for (int ai = 0; ai < 2; ++ai)
#pragma unroll
            for (int m = 0; m < 4; ++m) { asm volatile("" ::: "memory");
                const int row = EPI_ROWS(ai, m); const float rs = rs16(ssq16, row);
#pragma unroll
                for (int bj = 0; bj < 2; ++bj) { const int col0 = u.pn * 256 + bj * 128 + wc * 32 + fq * 8;
                    const u32x4 g = *(const u32x4*)(pe + (size_t)row * DM + col0), p = *(const u32x4*)(xb + (size_t)row * DM + col0);
                    const f32x4 pa = {bf_lo(g.x), bf_hi(g.x), bf_lo(g.y), bf_hi(g.y)}, pb = {bf_lo(g.z), bf_hi(g.z), bf_lo(g.w), bf_hi(g.w)};
                    f32x4 x0 = {bf_lo(p.x), bf_hi(p.x), bf_lo(p.y), bf_hi(p.y)}, x1 = {bf_lo(p.z), bf_hi(p.z), bf_lo(p.w), bf_hi(p.w)};
                    float* o = out + (size_t)row * DM + col0;
#pragma unroll
                    for (int e = 0; e < 4; ++e) { x0[e] += __builtin_amdgcn_rcpf(1.f + __builtin_amdgcn_exp2f(acc[ai][bj][m][0][e] * (-rs * LOG2E))) * pa[e]; x1[e] += __builtin_amdgcn_rcpf(1.f + __builtin_amdgcn_exp2f(acc[ai][bj][m][1][e] * (-rs * LOG2E))) * pb[e]; }
                    *(f32x4*)o = x0; *(f32x4*)(o + 4) = x1; }
            }
    }
};

template <class E> __device__ __forceinline__ void run_gemm(LAS unsigned char* lds, const bf16_t* A, const bf16_t* Bt, int M, int N, int K, const E& e) {
    A = (const bf16_t*)uniform_ptr(A); Bt = (const bf16_t*)uniform_ptr(Bt);
    pg8::Gemm g{A, Bt, M, N, K}; pg8::StaticOrder S; S.init(M, N, (int)gridDim.x, (int)blockIdx.x);
    pg8::gemm_phase<E, pg8::StaticOrder, true, true>(lds, g, S, e);
}

struct WDesc { const float* src; const float* src2; const float* gain; bf16_t* dst; int K, Nsrc, Ndst, map; };
__device__ __forceinline__ int wcolmap(int map, int n, int& which) {
    which = 0;
    const int tp = n & 255, bj = tp >> 7, wc = (tp >> 5) & 3, c = tp & 31;
    switch (map) {
    case 0: return n;
    case 1: which = bj; return (n >> 8) * 128 + (tp & 127);
    case 2: { const int g = n / 1536, nn = n - g * 1536, pn = nn >> 8, s = pn >> 1, hh = pn & 1, h = hh * 4 + wc, p = bj * 32 + c;
              const int d = (s < 2 && p < 16) ? (4 * (p >> 3) + 8 * ((p >> 2) & 1) + (p & 3)) : p; return 832 + g * 1536 + s * 512 + h * 64 + d; }
    case 3: { if (n < 768) return n; const int t = n - 768; if (t < 32) return 768 + t; if (t >= 128 && t < 160) return 800 + (t - 128); return -1; }
    case 4: { if (wc == 3) return -1; return (n >> 8) * 192 + wc * 64 + bj * 32 + c; }
    case 5: { const int h = n >> 8; return wc < 2 ? h * 256 + wc * 64 + bj * 32 + c : h * 256 + 128 + (wc - 2) * 64 + bj * 32 + c; }
    case 6: return 5440 + n;
    }
    return -1;
}
__device__ __forceinline__ void transpose_item(const WDesc& d, LAS float* scr, int item, int lane) {
    const int nblk = d.Ndst / 32, kb = item / nblk, nb = item - kb * nblk, k0 = 64 * kb, n0 = 32 * nb;
    int which; const int col = wcolmap(d.map, n0 + (lane & 31), which); const bool up = (d.map == 1) && (((n0 >> 7) & 1) != 0); const float* src = (const float*)uniform_ptr(up ? d.src2 : d.src);
    float tv[32];
#pragma unroll
    for (int i = 0; i < 32; ++i) { const int kk = 2 * i + (lane >> 5); float v = 0.f; if (col >= 0) { v = src[(size_t)(k0 + kk) * d.Nsrc + col]; } tv[i] = v; }
#pragma unroll
    for (int i = 0; i < 32; ++i) { const int kk = 2 * i + (lane >> 5); float v = tv[i]; if (d.gain) v *= d.gain[k0 + kk]; scr[kk * 33 + (lane & 31)] = v; }
    asm volatile("s_waitcnt lgkmcnt(0)" ::: "memory");
    const int c = lane & 7;
#pragma unroll
    for (int j = 0; j < 4; ++j) { const int n = (lane >> 3) + 8 * j; const LAS float* s = scr + (8 * c) * 33 + n;
        u32x4 o; o.x = cvt_pk_bf16(s[0 * 33], s[1 * 33]); o.y = cvt_pk_bf16(s[2 * 33], s[3 * 33]); o.z = cvt_pk_bf16(s[4 * 33], s[5 * 33]); o.w = cvt_pk_bf16(s[6 * 33], s[7 * 33]);
        *(u32x4*)(d.dst + (size_t)(n0 + n) * d.K + k0 + 8 * c) = o; }
    asm volatile("s_waitcnt lgkmcnt(0)" ::: "memory");
}
__device__ __forceinline__ float wave_sum(float v) {
#pragma unroll
    for (int o = 1; o < 64; o <<= 1) v += __shfl_xor(v, o);
    return v;
}
__device__ __forceinline__ void prologue(CParams& P, LAS unsigned char* lds) {
    int tid_ = threadIdx.x; asm volatile("" : "+v"(tid_));
    const int tid = tid_, lane = tid & 63, wave = tid >> 6; const int gw = blockIdx.x * 8 + wave, NGW = gridDim.x * 8;
    LAS float* scr = (LAS float*)(lds + wave * 16384);
    int base = 0; unsigned char* ws = P.ws;
#define WCONV(SRC, SRC2, GAIN, DSTOFF, KK, NSRC, NDST, MAP) { const WDesc d{SRC, SRC2, GAIN, (bf16_t*)(ws + (DSTOFF)), KK, NSRC, NDST, MAP}; constexpr int items = ((KK) / 64) * ((NDST) / 32); \
        for (int it = (gw - base % NGW + NGW) % NGW; it < items; it += NGW) transpose_item(d, scr, it, lane); base += items; asm volatile("" ::: "memory"); }
    WCONV(P.in[5], P.in[6], P.in[4], W_GU1, 1024, 2816, 5632, 1)
    WCONV(P.in[7], nullptr, nullptr, W_D1, 2816, 1024, 1024, 0)
    WCONV(P.in[22], P.in[23], P.in[21], W_GU2, 1024, 2816, 5632, 1)
    WCONV(P.in[24], nullptr, nullptr, W_D2, 2816, 1024, 1024, 0)
    WCONV(P.in[9], nullptr, P.in[8], W_DIL, 1024, 7488, 4608, 2)
    WCONV(P.in[9], nullptr, P.in[8], W_A, 1024, 7488, 1024, 3)
    WCONV(P.in[11], nullptr, P.in[10], W_UQ, 512, 1536, 2048, 4)
    WCONV(P.in[13], nullptr, P.in[12], W_UKV, 256, 2048, 2048, 5)
    WCONV(P.in[9], nullptr, P.in[8], W_G, 1024, 7488, 2048, 6)
    WCONV(P.in[18], nullptr, nullptr, W_OA, 1024, 1024, 1024, 0)
    WCONV(P.in[19], nullptr, nullptr, W_OB, 512, 1024, 1024, 0)
    WCONV(P.in[20], nullptr, nullptr, W_OUT, 1024, 1024, 1024, 0)
    WCONV(P.in[27], nullptr, P.in[25], W_PG, 1024, 1024, 1024, 0)
    WCONV(P.in[26], nullptr, nullptr, W_PE, 256, 1024, 1024, 0)
#undef WCONV
    bf16_t* XB = (bf16_t*)(P.ws + XB_OFF); float* RS0 = (float*)(P.ws + S_RS0);
    for (int m = gw; m < T; m += NGW) { const float* xr = m < TP ? P.in[0] + (size_t)m * DM : P.in[1] + (size_t)(m - TP) * DM;
        f32x4 v[4]; float s = 0.f;
#pragma unroll
        for (int j = 0; j < 4; ++j) { v[j] = ((const f32x4*)xr)[lane + 64 * j]; s += dot4(v[j]); }
        s = wave_sum(s);
#pragma unroll
        for (int j = 0; j < 4; ++j) { u32x2 w; w.x = cvt_pk_bf16(v[j][0], v[j][1]); w.y = cvt_pk_bf16(v[j][2], v[j][3]); ((u32x2*)(XB + (size_t)m * DM))[lane + 64 * j] = w; }
        if (lane == 0) RS0[m] = rsqrtf(s * (1.f / 1024.f) + EPS); }
    float* mcos = (float*)(P.ws + S_MCOS); float* msin = (float*)(P.ws + S_MSIN); float* dcos = (float*)(P.ws + S_DCOS); float* dsin = (float*)(P.ws + S_DSIN);
    const int gt = blockIdx.x * 512 + tid, NT = gridDim.x * 512;
    for (int i = gt; i < 16384 * 40; i += NT) { const bool big = i < 16384 * 32; const int j = big ? i : i - 16384 * 32; const int pos = big ? (j >> 5) : (j >> 3), f = big ? (j & 31) : (j & 7);
        const double inv = exp2(-18.931568569324174 * (double)f / (big ? 32.0 : 8.0)); double xr = (double)pos * inv * 0.15915494309189535; xr -= floor(xr); const float rev = (float)xr;
        const float cs = __builtin_amdgcn_cosf(rev), sn = __builtin_amdgcn_sinf(rev);
        if (big) { mcos[j] = cs; msin[j] = sn; } else { dcos[j] = cs; dsin[j] = sn; } }
}

__device__ __forceinline__ bf16x8 vtr8(const LAS unsigned char* lo, const LAS unsigned char* hi) {
    const v4i16_t a = __builtin_amdgcn_ds_read_tr16_b64_v4i16((LAS v4i16_t*)lo), b = __builtin_amdgcn_ds_read_tr16_b64_v4i16((LAS v4i16_t*)hi);
    return (bf16x8){a[0], a[1], a[2], a[3], b[0], b[1], b[2], b[3]};
}
constexpr int MLA_KP = 400, MLA_KB = 64 * MLA_KP, MLA_VB = 16384, MLA_VOFF = 3 * MLA_KB;
__device__ __forceinline__ void mla_unit(LAS unsigned char* lds, const bf16_t* Qg, const bf16_t* Kg, const bf16_t* Vg, bf16_t* Og, int qrow0, int krow0, int nkt, int h, size_t orow0) {
    int tid_ = threadIdx.x; asm volatile("" : "+v"(tid_));
    const int tid = tid_, lane = tid & 63, wave = tid >> 6, l31 = lane & 31, hi = lane >> 5;
    bf16x8 qf[12];
    { const bf16_t* qp = Qg + (size_t)(qrow0 + wave * 32 + l31) * 1536 + h * 192 + hi * 8;
#pragma unroll
      for (int ks = 0; ks < 12; ++ks) qf[ks] = *(const bf16x8*)(qp + ks * 16); }
    const int skey = tid >> 3, sc8 = tid & 7;
    const bf16_t* kbase = Kg + (size_t)(krow0 + skey) * 1536 + h * 192 + sc8 * 8; const bf16_t* vbase = Vg + (size_t)(krow0 + skey) * 1024 + h * 128 + sc8 * 8;
    const int klds = skey * MLA_KP + sc8 * 16, vlds = MLA_VOFF + ((skey >> 3) * 4 + (sc8 >> 2)) * 512 + (skey & 7) * 64 + (sc8 & 3) * 16;
    u32x4 kr[3], vr[2];
#define MLA_LOADK(t) do { _Pragma("unroll") for (int i = 0; i < 3; ++i) kr[i] = *(const u32x4*)(kbase + (size_t)(t) * (64 * 1536) + i * 64); } while (0)
#define MLA_LOADV(t) do { _Pragma("unroll") for (int i = 0; i < 2; ++i) vr[i] = *(const u32x4*)(vbase + (size_t)(t) * (64 * 1024) + i * 64); } while (0)
#define MLA_STOREK(off) do { _Pragma("unroll") for (int i = 0; i < 3; ++i) *(LAS u32x4*)(lds + (off) + klds + i * 128) = kr[i]; } while (0)
#define MLA_STOREV(off) do { _Pragma("unroll") for (int i = 0; i < 2; ++i) *(LAS u32x4*)(lds + (off) + vlds + i * 1024) = vr[i]; } while (0)
    f32x16 O[4];
#pragma unroll
    for (int dt = 0; dt < 4; ++dt)
#pragma unroll
        for (int r = 0; r < 16; ++r) O[dt][r] = 0.f;
    float mrun = -INFINITY, lrun = 0.f;
    const int koff = l31 * MLA_KP + hi * 16;
    const int voff = MLA_VOFF + (4 * hi + ((lane & 15) >> 2)) * 64 + (((lane >> 4) & 1) * 16 + (lane & 3) * 4) * 2;
    f32x16 sa0, sa1, sb0, sb1; bf16x8 pf[4];
#define MLA_QK(S0, S1, KOFF) do { const LAS unsigned char* sb_ = lds + (KOFF); \
        _Pragma("unroll") for (int r = 0; r < 16; ++r) { S0[r] = 0.f; S1[r] = 0.f; } \
        bf16x8 kq[2][2]; \
        kq[0][0] = *(const LAS bf16x8*)(sb_ + koff); kq[0][1] = *(const LAS bf16x8*)(sb_ + koff + 32 * MLA_KP); \
        _Pragma("unroll") for (int ks = 0; ks < 12; ++ks) { \
            if (ks < 11) { kq[(ks + 1) & 1][0] = *(const LAS bf16x8*)(sb_ + koff + (ks + 1) * 32); kq[(ks + 1) & 1][1] = *(const LAS bf16x8*)(sb_ + koff + 32 * MLA_KP + (ks + 1) * 32); } \
            S0 = __builtin_amdgcn_mfma_f32_32x32x16_bf16(kq[ks & 1][0], qf[ks], S0, 0, 0, 0); S1 = __builtin_amdgcn_mfma_f32_32x32x16_bf16(kq[ks & 1][1], qf[ks], S1, 0, 0, 0); } } while (0)
#define MLA_SM(S0, S1) do { float mx = fmaxf(S0[0], S1[0]); \
        _Pragma("unroll") for (int r = 1; r < 16; ++r) mx = fmaxf(mx, fmaxf(S0[r], S1[r])); \
        { const auto rr_ = __builtin_amdgcn_permlane32_swap(__float_as_uint(mx), __float_as_uint(mx), false, false); mx = fmaxf(__uint_as_float(rr_[0]), __uint_as_float(rr_[1])); } \
        if (__any(mx > mrun + 6.0f)) { const float mnew = fmaxf(mrun, mx), alpha = __builtin_amdgcn_exp2f(mrun - mnew); mrun = mnew; lrun *= alpha; \
            _Pragma("unroll") for (int dt = 0; dt < 4; ++dt) _Pragma("unroll") for (int r = 0; r < 16; ++r) O[dt][r] *= alpha; } \
        float ls = 0.f; \
        _Pragma("unroll") for (int r = 0; r < 16; ++r) { S0[r] = __builtin_amdgcn_exp2f(S0[r] - mrun); S1[r] = __builtin_amdgcn_exp2f(S1[r] - mrun); ls += S0[r] + S1[r]; } \
        lrun += ls; \
        _Pragma("unroll") for (int j = 0; j < 2; ++j) { u32x4 w0, w1; \
            w0.x = cvt_pk_bf16(S0[8 * j + 0], S0[8 * j + 1]); w0.y = cvt_pk_bf16(S0[8 * j + 2], S0[8 * j + 3]); w0.z = cvt_pk_bf16(S0[8 * j + 4], S0[8 * j + 5]); w0.w = cvt_pk_bf16(S0[8 * j + 6], S0[8 * j + 7]); \
            w1.x = cvt_pk_bf16(S1[8 * j + 0], S1[8 * j + 1]); w1.y = cvt_pk_bf16(S1[8 * j + 2], S1[8 * j + 3]); w1.z = cvt_pk_bf16(S1[8 * j + 4], S1[8 * j + 5]); w1.w = cvt_pk_bf16(S1[8 * j + 6], S1[8 * j + 7]); \
            pf[j] = __builtin_bit_cast(bf16x8, w0); pf[2 + j] = __builtin_bit_cast(bf16x8, w1); } } while (0)
#define MLA_PV(VOFFB) do { const LAS unsigned char* sb_ = lds + (VOFFB); bf16x8 vq[2][2]; \
        vq[0][0] = vtr8(sb_ + voff, sb_ + voff + 4 * 512); vq[0][1] = vtr8(sb_ + voff + 512, sb_ + voff + 5 * 512); \
        _Pragma("unroll") for (int st = 0; st < 8; ++st) { const int kg = st >> 1, dp = st & 1; \
            if (st < 7) { const int kg2 = (st + 1) >> 1, dp2 = (st + 1) & 1; \
                vq[(st + 1) & 1][0] = vtr8(sb_ + voff + ((2 * kg2) * 4 + 2 * dp2) * 512, sb_ + voff + ((2 * kg2 + 1) * 4 + 2 * dp2) * 512); \
                vq[(st + 1) & 1][1] = vtr8(sb_ + voff + ((2 * kg2) * 4 + 2 * dp2 + 1) * 512, sb_ + voff + ((2 * kg2 + 1) * 4 + 2 * dp2 + 1) * 512); } \
            O[2 * dp] = __builtin_amdgcn_mfma_f32_32x32x16_bf16(vq[st & 1][0], pf[kg], O[2 * dp], 0, 0, 0); \
            O[2 * dp + 1] = __builtin_amdgcn_mfma_f32_32x32x16_bf16(vq[st & 1][1], pf[kg], O[2 * dp + 1], 0, 0, 0); } } while (0)
#define MLA_STEP(t, SC0, SC1, SN0, SN1) do { const bool more1 = ((t) + 1 < nkt), more2 = ((t) + 2 < nkt); \
        if (more1) { MLA_QK(SN0, SN1, k_nxt); } \
        if (more2) MLA_LOADK((t) + 2); \
        MLA_SM(SC0, SC1); \
        if (more1) MLA_LOADV((t) + 1); \
        MLA_PV(((t) & 1) * MLA_VB); \
        if (more2) MLA_STOREK(k_prv); \
        if (more1) MLA_STOREV((((t) + 1) & 1) * MLA_VB); \
        __syncthreads(); \
        { const int tmp_ = k_prv; k_prv = k_cur; k_cur = k_nxt; k_nxt = tmp_; } } while (0)
    { u32x4 k1r[3];
      MLA_LOADK(0); MLA_LOADV(0);
#pragma unroll
      for (int i = 0; i < 3; ++i) k1r[i] = *(const u32x4*)(kbase + (size_t)(64 * 1536) + i * 64);
      MLA_STOREK(0); MLA_STOREV(0);
#pragma unroll
      for (int i = 0; i < 3; ++i) *(LAS u32x4*)(lds + MLA_KB + klds + i * 128) = k1r[i]; }
    __syncthreads();
    int k_cur = 0, k_nxt = MLA_KB, k_prv = 2 * MLA_KB;
    MLA_QK(sa0, sa1, k_cur);
    for (int t = 0; t < nkt; t += 2) {
        MLA_STEP(t, sa0, sa1, sb0, sb1);
        MLA_STEP(t + 1, sb0, sb1, sa0, sa1);
    }
    lrun += __shfl_xor(lrun, 32);
    const float inv = 1.f / lrun;
    bf16_t* op = Og + (orow0 + wave * 32 + l31) * 1024 + h * 128 + 4 * hi;
#pragma unroll
    for (int dt = 0; dt < 4; ++dt)
#pragma unroll
        for (int a = 0; a < 4; ++a) { u32x2 w; w.x = cvt_pk_bf16(O[dt][4 * a] * inv, O[dt][4 * a + 1] * inv); w.y = cvt_pk_bf16(O[dt][4 * a + 2] * inv, O[dt][4 * a + 3] * inv);
            *(u32x2*)(op + dt * 32 + a * 8) = w; }
#undef MLA_LOADK
#undef MLA_LOADV
#undef MLA_STOREK
#undef MLA_STOREV
#undef MLA_QK
#undef MLA_SM
#undef MLA_PV
#undef MLA_STEP
}
__device__ __forceinline__ void mla_phase(LAS unsigned char* lds, CParams& P, int chunk) {
    const bf16_t* Qg = (const bf16_t*)(P.ws + R_Q); const bf16_t* Kg = (const bf16_t*)(P.ws + R_K); const bf16_t* Vg = (const bf16_t*)(P.ws + R_V); bf16_t* Og = (bf16_t*)(P.ws + R_OM);
    const int G = gridDim.x, nbig = chunk == 0 ? 512 : 0, ntot = 1280;
    for (int idx = blockIdx.x; idx < ntot; idx += G) {
        int h, qrow0, krow0, nkt;
        if (idx < nbig) { h = idx & 7; krow0 = 0; qrow0 = (idx >> 3) * 256; nkt = 256; }
        else { const int s = idx - nbig; h = s & 7; const int qb = (s >> 3) & 7, seq = s >> 6; krow0 = (chunk == 0 ? TP : 0) + seq * SS; qrow0 = krow0 + qb * 256; nkt = 32; }
        mla_unit(lds, Qg, Kg, Vg, Og, qrow0, krow0, nkt, h, (size_t)chunk * CH + qrow0);
    }
}

__device__ __forceinline__ void dil_phase(LAS unsigned char* lds, CParams& P, int g) {
    const bf16_t* DIL = (const bf16_t*)(P.ws + R_DIL);
    const int sh = 2 * g, dmask = (1 << sh) - 1;
    int tid_ = threadIdx.x; asm volatile("" : "+v"(tid_));
    const int tid = tid_, lane = tid & 63, wave = tid >> 6, hb = wave >> 2, w = wave & 3, tl = tid & 255, l31 = lane & 31, hi = lane >> 5;
    LAS unsigned char* vb = lds + hb * 32768;
    const int voff = (4 * hi + ((lane & 15) >> 2)) * 64 + (((lane >> 4) & 1) * 16 + (lane & 3) * 4) * 2;
    u32x4 vr[8];
#define DIL_VLOAD(BU) do { const int su_ = 2 * (BU) + hb; int t0_, S_, loc_; \
        if (su_ < 1024) { t0_ = 0; S_ = TP; loc_ = su_; } else { const int s_ = (su_ - 1024) >> 7; t0_ = TP + s_ * SS; S_ = SS; loc_ = (su_ - 1024) & 127; } \
        const int h_ = loc_ & 7, rest_ = loc_ >> 3, r_ = rest_ & dmask, qb_ = rest_ >> sh, L_ = S_ >> sh, subb_ = 128 * qb_ - 64; \
        _Pragma("unroll") for (int i = 0; i < 8; ++i) { const int c = tl + 256 * i, key = c >> 3, ch = c & 7; int sub = subb_ + key; sub = sub < 0 ? 0 : (sub > L_ - 1 ? L_ - 1 : sub); \
            vr[i] = *(const u32x4*)(DIL + (size_t)(t0_ + (sub << sh) + r_) * 1536 + 1024 + h_ * 64 + ch * 8); } } while (0)
    if ((int)blockIdx.x < 2560) DIL_VLOAD((int)blockIdx.x);
    for (int bu = blockIdx.x; bu < 2560; bu += gridDim.x) {
        const int su = 2 * bu + hb; int t0, S, loc;
        if (su < 1024) { t0 = 0; S = TP; loc = su; } else { const int s = (su - 1024) >> 7; t0 = TP + s * SS; S = SS; loc = (su - 1024) & 127; }
        const int h = loc & 7, rest = loc >> 3, r = rest & dmask, qb = rest >> sh, L = S >> sh, sub_b = 128 * qb - 64;
#pragma unroll
        for (int i = 0; i < 8; ++i) { const int c = tl + 256 * i, key = c >> 3, ch = c & 7; *(LAS u32x4*)(vb + ((key >> 3) * 2 + (ch >> 2)) * 512 + (key & 7) * 64 + (ch & 3) * 16) = vr[i]; }
        asm volatile("" ::: "memory");
        const int qsub = 128 * qb + 32 * w + l31; const size_t tokq = (size_t)(t0 + (qsub << sh) + r);
        bf16x8 qf[4];
#pragma unroll
        for (int ks = 0; ks < 4; ++ks) qf[ks] = *(const bf16x8*)(DIL + tokq * 1536 + h * 64 + ks * 16 + hi * 8);
        f32x16 sc[5];
        bf16x8 kfr[5][4];
#pragma unroll
        for (int kt = 0; kt < 5; ++kt) { int sub = sub_b + 32 * w + 32 * kt + l31; sub = sub < 0 ? 0 : (sub > L - 1 ? L - 1 : sub);
            const bf16_t* kp = DIL + (size_t)(t0 + (sub << sh) + r) * 1536 + 512 + h * 64 + hi * 8;
#pragma unroll
            for (int ks = 0; ks < 4; ++ks) kfr[kt][ks] = *(const bf16x8*)(kp + ks * 16); }
        if (bu + (int)gridDim.x < 2560) DIL_VLOAD(bu + (int)gridDim.x);
#pragma unroll
        for (int kt = 0; kt < 5; ++kt) {
#pragma unroll
            for (int r2 = 0; r2 < 16; ++r2) sc[kt][r2] = 0.f;
#pragma unroll
            for (int ks = 0; ks < 4; ++ks) sc[kt] = __builtin_amdgcn_mfma_f32_32x32x16_bf16(kfr[kt][ks], qf[ks], sc[kt], 0, 0, 0);
        }
        float mx = -INFINITY;
#pragma unroll
        for (int kt = 0; kt < 5; ++kt)
#pragma unroll
            for (int r2 = 0; r2 < 16; ++r2) { const int keyl = (r2 & 3) + 8 * (r2 >> 2) + 4 * hi; const int rel = -64 + 32 * kt + keyl - l31; const int ksub = sub_b + 32 * w + 32 * kt + keyl;
                const bool ok = (rel >= -64) && (rel <= 64) && (ksub >= 0) && (ksub < L); sc[kt][r2] = ok ? sc[kt][r2] : -INFINITY; mx = fmaxf(mx, sc[kt][r2]); }
        { const auto rr_ = __builtin_amdgcn_permlane32_swap(__float_as_uint(mx), __float_as_uint(mx), false, false); mx = fmaxf(__uint_as_float(rr_[0]), __uint_as_float(rr_[1])); }
        float ls = 0.f;
#pragma unroll
        for (int kt = 0; kt < 5; ++kt)
#pragma unroll
            for (int r2 = 0; r2 < 16; ++r2) { sc[kt][r2] = __builtin_amdgcn_exp2f(sc[kt][r2] - mx); ls += sc[kt][r2]; }
        { const auto rr_ = __builtin_amdgcn_permlane32_swap(__float_as_uint(ls), __float_as_uint(ls), false, false); ls = __uint_as_float(rr_[0]) + __uint_as_float(rr_[1]); }
        __syncthreads();
        f32x16 O[2];
#pragma unroll
        for (int dt = 0; dt < 2; ++dt)
#pragma unroll
            for (int r2 = 0; r2 < 16; ++r2) O[dt][r2] = 0.f;
#pragma unroll
        for (int kt = 0; kt < 5; ++kt)
#pragma unroll
            for (int j = 0; j < 2; ++j) {
                u32x4 pw; pw.x = cvt_pk_bf16(sc[kt][8 * j + 0], sc[kt][8 * j + 1]); pw.y = cvt_pk_bf16(sc[kt][8 * j + 2], sc[kt][8 * j + 3]); pw.z = cvt_pk_bf16(sc[kt][8 * j + 4], sc[kt][8 * j + 5]); pw.w = cvt_pk_bf16(sc[kt][8 * j + 6], sc[kt][8 * j + 7]);
                const bf16x8 pf = __builtin_bit_cast(bf16x8, pw); const int kg = 2 * w + 2 * kt + j;
#pragma unroll
                for (int dt = 0; dt < 2; ++dt) { const bf16x8 vf = vtr8(vb + voff + ((2 * kg) * 2 + dt) * 512, vb + voff + ((2 * kg + 1) * 2 + dt) * 512);
                    O[dt] = __builtin_amdgcn_mfma_f32_32x32x16_bf16(vf, pf, O[dt], 0, 0, 0); }
            }
        const float inv = 1.f / ls, lse = mx + __builtin_amdgcn_logf(ls);
        if (g < 2) { bf16_t* Og = (bf16_t*)(P.ws + (g == 0 ? R_O0 : R_O1)); float* Lg = (float*)(P.ws + (g == 0 ? S_L0 : S_L1));
#pragma unroll
            for (int dt = 0; dt < 2; ++dt)
#pragma unroll
                for (int a = 0; a < 4; ++a) { u32x2 wv; wv.x = cvt_pk_bf16(O[dt][4 * a] * inv, O[dt][4 * a + 1] * inv); wv.y = cvt_pk_bf16(O[dt][4 * a + 2] * inv, O[dt][4 * a + 3] * inv);
                    *(u32x2*)(Og + tokq * 512 + h * 64 + dt * 32 + a * 8 + 4 * hi) = wv; }
            if (hi == 0) Lg[(size_t)h * T + t0 + r * L + qsub] = lse;
        } else { bf16_t* Og = (bf16_t*)(P.ws + R_OD); const bf16_t* O0 = (const bf16_t*)(P.ws + R_O0); const bf16_t* O1 = (const bf16_t*)(P.ws + R_O1); const float* L0 = (const float*)(P.ws + S_L0); const float* L1 = (const float*)(P.ws + S_L1);
            const int pos = (qsub << sh) + r; const float l0 = L0[(size_t)h * T + t0 + pos], l1 = L1[(size_t)h * T + t0 + (pos & 3) * (S >> 2) + (pos >> 2)]; const float mm = fmaxf(fmaxf(l0, l1), lse);
            float w0 = __builtin_amdgcn_exp2f(l0 - mm), w1 = __builtin_amdgcn_exp2f(l1 - mm), w2 = __builtin_amdgcn_exp2f(lse - mm); const float wi = 1.f / (w0 + w1 + w2);
            w0 *= wi; w1 *= wi; w2 *= wi * inv;
#pragma unroll
            for (int dt = 0; dt < 2; ++dt)
#pragma unroll
                for (int a = 0; a < 4; ++a) { const size_t off = tokq * 512 + h * 64 + dt * 32 + a * 8 + 4 * hi; const u32x2 a0 = *(const u32x2*)(O0 + off), a1 = *(const u32x2*)(O1 + off);
                    const float o0 = w0 * bf_lo(a0.x) + w1 * bf_lo(a1.x) + w2 * O[dt][4 * a], o1 = w0 * bf_hi(a0.x) + w1 * bf_hi(a1.x) + w2 * O[dt][4 * a + 1],
                                o2 = w0 * bf_lo(a0.y) + w1 * bf_lo(a1.y) + w2 * O[dt][4 * a + 2], o3 = w0 * bf_hi(a0.y) + w1 * bf_hi(a1.y) + w2 * O[dt][4 * a + 3];
                    u32x2 wv; wv.x = cvt_pk_bf16(o0, o1); wv.y = cvt_pk_bf16(o2, o3); *(u32x2*)(Og + off) = wv; }
        }
        __syncthreads();
    }
}


#define XB_TMO      128
#define XB_XCNT(j)  (256  + 64 * (j))
#define XB_XSUB(j)  (1280 + 64 * (j))
#define XB_XGEN(j)  (2304 + 64 * (j))
#define XB_TOP      3328
#define XB_TOPGEN   3392
#define XCD_BAR_WORDS 3456
#define XB_SPIN_CAP (1u << 28)

__device__ __forceinline__ unsigned xb_ld(unsigned* p)              { return __hip_atomic_load(p, __ATOMIC_RELAXED, __HIP_MEMORY_SCOPE_AGENT); }
__device__ __forceinline__ unsigned xb_add(unsigned* p, unsigned v) { return __hip_atomic_fetch_add(p, v, __ATOMIC_RELAXED, __HIP_MEMORY_SCOPE_AGENT); }
__device__ __forceinline__ unsigned xb_xcc_id() { return (unsigned)__builtin_amdgcn_s_getreg((3 << 11) | 20) & 0xFu; }
#define XB_SPIN(cond, bar) do { unsigned _sp = 0; while (cond) { __builtin_amdgcn_s_sleep(1); \
    if ((++_sp & 255u) == 0u) { if (xb_ld(&(bar)[XB_TMO])) break; if (_sp > XB_SPIN_CAP) { atomicAdd(&(bar)[XB_TMO], 1u); break; } } } } while (0)

struct XcdBarrier {
    unsigned* bar; unsigned x;
    volatile LAS unsigned* st;
};

__device__ __forceinline__ XcdBarrier xcd_barrier_post(unsigned* bar, volatile LAS unsigned* st) {
    XcdBarrier b; b.bar = bar; b.x = xb_xcc_id(); b.st = st;
    if (threadIdx.x == 0) (void)xb_add(&bar[XB_XCNT(b.x)], 1u);
    return b;
}
__device__ __forceinline__ void xcd_barrier_complete(unsigned* bar, unsigned x, unsigned& nloc, unsigned& nx) {
    const unsigned G = gridDim.x * gridDim.y * gridDim.z;
    unsigned sum, cnt, mine, sp = 0u;
    for (;;) {
        sum = 0u; cnt = 0u; mine = 0u;
#pragma unroll
        for (unsigned j = 0; j < 16; ++j) { const unsigned c = xb_ld(&bar[XB_XCNT(j)]); sum += c; cnt += (c > 0u) ? 1u : 0u; mine = (j == x) ? c : mine; }
        if (sum == G) break;
        __builtin_amdgcn_s_sleep(1);
        if ((++sp & 255u) == 0u) { if (xb_ld(&bar[XB_TMO])) break; if (sp > XB_SPIN_CAP) { atomicAdd(&bar[XB_TMO], 1u); break; } }
    }
    nloc = mine > 0u ? mine : 1u; nx = cnt > 0u ? cnt : 1u;
}

__device__ __forceinline__ void xcd_barrier(const XcdBarrier& b) {
    asm volatile("s_waitcnt vmcnt(0)" ::: "memory");
    __syncthreads();
    if (threadIdx.x == 0) {
        unsigned* bar = b.bar;
        __builtin_amdgcn_s_waitcnt(0);
        unsigned nloc = b.st[0], nx = b.st[1];
        if (nloc == 0u) { xcd_barrier_complete(bar, b.x, nloc, nx); b.st[0] = nloc; b.st[1] = nx; }
        const unsigned old = xb_add(&bar[XB_XSUB(b.x)], 1u);
        const unsigned gen = old / nloc;
        if (old + 1u == (gen + 1u) * nloc) {
            __builtin_amdgcn_fence(__ATOMIC_RELEASE, "agent");
            asm volatile("s_waitcnt vmcnt(0)" ::: "memory");
            const unsigned og = xb_add(&bar[XB_TOP], 1u);
            const unsigned tg = og / nx;
            if (og + 1u == (tg + 1u) * nx) xb_add(&bar[XB_TOPGEN], 1u);
            else XB_SPIN(xb_ld(&bar[XB_TOPGEN]) == tg, bar);
            __builtin_amdgcn_fence(__ATOMIC_ACQUIRE, "");
            xb_add(&bar[XB_XGEN(b.x)], 1u);
            asm volatile("s_waitcnt vmcnt(0)" ::: "memory");
        } else {
            XB_SPIN(xb_ld(&bar[XB_XGEN(b.x)]) == gen, bar);
            __builtin_amdgcn_fence(__ATOMIC_ACQUIRE, "agent");
            asm volatile("s_waitcnt vmcnt(0)" ::: "memory");
        }
    }
    __syncthreads();
}


__device__ __forceinline__ void dbg_dump(float* out, const bf16_t* src, int ncols) {
    const size_t n = (size_t)T * ncols; const size_t gt = (size_t)blockIdx.x * 512 + threadIdx.x, NT = (size_t)gridDim.x * 512;
    for (size_t i = gt; i < n; i += NT) { const size_t row = i / ncols, c = i - row * ncols; out[row * DM + c] = bf_lo((unsigned)src[i]); }
}
#ifndef DBG_STOP
#define DBG_STOP 0
#endif
#undef DIL_VLOAD
#define FRESH() CParams& P = *pp; unsigned char* ws = P.ws; bf16_t* XB = (bf16_t*)(ws + XB_OFF); bf16_t* H = (bf16_t*)(ws + R_H); (void)XB; (void)H; \
    float* SSQ1 = (float*)(ws + S_SSQ1); float* SSQ2 = (float*)(ws + S_SSQ2); float* SSQ3 = (float*)(ws + S_SSQ3); (void)SSQ1; (void)SSQ2; (void)SSQ3; \
    const float* mcos = (const float*)(ws + S_MCOS); const float* msin = (const float*)(ws + S_MSIN); const float* dcos = (const float*)(ws + S_DCOS); const float* dsin = (const float*)(ws + S_DSIN); (void)mcos; (void)msin; (void)dcos; (void)dsin;
#define GSYNC() do { XcdBarrier xb_; xb_.bar = (unsigned*)(pp->ws + S_CTL); xb_.x = xb_xcc_id(); xb_.st = (volatile LAS unsigned*)(lds + LDS_SCR + 8192); xcd_barrier(xb_); asm volatile("" : "+s"(pp) :: "memory"); } while (0)
__global__ void __launch_bounds__(512) mega_fwd(Params Pbyval) {
    extern __shared__ __attribute__((aligned(16))) unsigned char lds_raw[];
    LAS unsigned char* lds = (LAS unsigned char*)lds_raw;
    LAS float* scr = (LAS float*)(lds + LDS_SCR);
    cg::grid_group grid = cg::this_grid();
    CParams* pp = (CParams*)__builtin_amdgcn_kernarg_segment_ptr();
    asm volatile("" : "+s"(pp) :: "memory");
    volatile LAS unsigned* xst = (volatile LAS unsigned*)(lds + LDS_SCR + 8192);
    if (threadIdx.x < 2) xst[threadIdx.x] = 0u;
    __syncthreads();
    (void)xcd_barrier_post((unsigned*)(pp->ws + S_CTL), xst);
    grid.sync();

    { FRESH(); prologue(P, lds); }
#ifdef PROBE_PROL2
    GSYNC();
    { FRESH(); prologue(P, lds); }
#endif
    GSYNC();
    { FRESH(); EpiSwiglu e{(const float*)(ws + S_RS0), nullptr, H}; run_gemm(lds, XB, (const bf16_t*)(ws + W_GU1), T, 5632, 1024, e); }
#ifdef PROBE_G1X2
    GSYNC();
    { FRESH(); EpiSwiglu e{(const float*)(ws + S_RS0), nullptr, H}; run_gemm(lds, XB, (const bf16_t*)(ws + W_GU1), T, 5632, 1024, e); }
#endif
    GSYNC();
    { FRESH(); EpiResid<false> e{P.in[0], P.in[1], XB, SSQ1, 0.5f, scr}; run_gemm(lds, H, (const bf16_t*)(ws + W_D1), T, 1024, FF, e); }
    GSYNC();
    if (DBG_STOP == 1) return;
    if (DBG_STOP == 11) { { FRESH(); EpiDil e{SSQ1, P.in[16], P.in[17], dcos, dsin, (bf16_t*)(ws + R_DIL)}; run_gemm(lds, XB, (const bf16_t*)(ws + W_DIL), T, 1536, 1024, e); }
        GSYNC();
        { FRESH(); const size_t gt = (size_t)blockIdx.x * 512 + threadIdx.x, NT = (size_t)gridDim.x * 512; const bf16_t* G = (const bf16_t*)(ws + R_DIL);
          for (size_t i = gt; i < (size_t)T * 1024; i += NT) { const size_t row = i >> 10, c = i & 1023; P.out[i] = bf_lo((unsigned)G[row * 1536 + c]) + bf_lo((unsigned)G[row * 1536 + 512 + c]); } } return; }
    for (int g = 0; g < ((DBG_STOP == 9 || DBG_STOP == 12) ? 0 : 3); ++g) {
        { FRESH(); EpiDil e{SSQ1, P.in[16] + g * 64, P.in[17] + g * 64, dcos, dsin, (bf16_t*)(ws + R_DIL)}; run_gemm(lds, XB, (const bf16_t*)(ws + W_DIL) + (size_t)g * 1536 * 1024, T, 1536, 1024, e); }
        GSYNC();
        { FRESH(); dil_phase(lds, P, g); }
#ifdef PROBE_DIL2
        GSYNC();
        { FRESH(); dil_phase(lds, P, g); }
#endif
        GSYNC();
    }
    if (DBG_STOP == 2) { FRESH(); dbg_dump(P.out, (const bf16_t*)(ws + R_OD), 512); return; }
    for (int c = 0; c < ((DBG_STOP == 9 || DBG_STOP == 12) ? 0 : 2); ++c) {
        const int row0 = c * CH;
        { FRESH(); EpiA e{SSQ1, (bf16_t*)(ws + R_CQ), (bf16_t*)(ws + R_CKV), (float*)(ws + S_SSQQ), (float*)(ws + S_SSQKV), (float*)(ws + S_SSQPE), (float*)(ws + S_KPE), P.in[15], mcos, msin, row0, scr};
          run_gemm(lds, XB + (size_t)row0 * DM, (const bf16_t*)(ws + W_A), CH, 1024, 1024, e); }
        GSYNC();
        { FRESH(); EpiQ e{(const float*)(ws + S_SSQQ), P.in[14], mcos, msin, (bf16_t*)(ws + R_Q), scr, row0}; run_gemm(lds, (const bf16_t*)(ws + R_CQ), (const bf16_t*)(ws + W_UQ), CH, 2048, 512, e); }
        { FRESH(); EpiKV e{(const float*)(ws + S_SSQKV), (const float*)(ws + S_SSQPE), (const float*)(ws + S_KPE), P.in[15], (bf16_t*)(ws + R_K), (bf16_t*)(ws + R_V), scr, row0};
          run_gemm(lds, (const bf16_t*)(ws + R_CKV), (const bf16_t*)(ws + W_UKV), CH, 2048, 256, e); }
        GSYNC();
        { FRESH(); mla_phase(lds, P, c); }
#ifdef PROBE_MLA2
        GSYNC();
        { FRESH(); mla_phase(lds, P, c); }
#endif
        GSYNC();
    }
    if (DBG_STOP == 3) { FRESH(); dbg_dump(P.out, (const bf16_t*)(ws + R_OM), 1024); return; }
#ifdef PROBE_BAR10
    for (int i = 0; i < 10; ++i) GSYNC();
#endif
    if (DBG_STOP == 12) { FRESH(); EpiEW<5> e{SSQ1, nullptr, 0, (bf16_t*)(ws + R_GATES), 2048}; run_gemm(lds, XB, (const bf16_t*)(ws + W_G), T, 2048, 1024, e); } else
    { FRESH(); EpiEW<0> e{SSQ1, nullptr, 0, (bf16_t*)(ws + R_GATES), 2048}; run_gemm(lds, XB, (const bf16_t*)(ws + W_G), T, 2048, 1024, e); }
#ifdef PROBE_P9X2
    GSYNC();
    { FRESH(); EpiEW<0> e{SSQ1, nullptr, 0, (bf16_t*)(ws + R_GATES), 2048}; run_gemm(lds, XB, (const bf16_t*)(ws + W_G), T, 2048, 1024, e); }
#endif
    GSYNC();
    if (DBG_STOP == 8 || DBG_STOP == 9 || DBG_STOP == 12) { FRESH(); const size_t gt = (size_t)blockIdx.x * 512 + threadIdx.x, NT = (size_t)gridDim.x * 512; const bf16_t* G = (const bf16_t*)(ws + R_GATES);
        for (size_t i = gt; i < (size_t)T * 1024; i += NT) { const size_t row = i >> 10, c = i & 1023; P.out[i] = bf_lo((unsigned)G[row * 2048 + c]) + bf_lo((unsigned)G[row * 2048 + 1024 + c]); } return; }
    { FRESH(); EpiEW<1> e{nullptr, (const bf16_t*)(ws + R_GATES), 2048, (bf16_t*)(ws + R_TT), 1024}; run_gemm(lds, (const bf16_t*)(ws + R_OM), (const bf16_t*)(ws + W_OA), T, 1024, 1024, e); }
    GSYNC();
    if (DBG_STOP == 6) { FRESH(); dbg_dump(P.out, (const bf16_t*)(ws + R_TT), 1024); return; }
    { FRESH(); EpiEW<2> e{nullptr, (const bf16_t*)(ws + R_GATES) + 1024, 2048, (bf16_t*)(ws + R_TT), 1024}; run_gemm(lds, (const bf16_t*)(ws + R_OD), (const bf16_t*)(ws + W_OB), T, 1024, 512, e); }
    GSYNC();
    if (DBG_STOP == 7) { FRESH(); dbg_dump(P.out, (const bf16_t*)(ws + R_TT), 1024); return; }
    { FRESH(); EpiResid<true> e{nullptr, nullptr, XB, SSQ2, 1.0f, scr}; run_gemm(lds, (const bf16_t*)(ws + R_TT), (const bf16_t*)(ws + W_OUT), T, 1024, 1024, e); }
    GSYNC();
    if (DBG_STOP == 4) return;
    { FRESH(); bf16_t* PB = (bf16_t*)(ws + R_PB); const int gt = blockIdx.x * 512 + threadIdx.x, NT = gridDim.x * 512;
      for (int i = gt; i < T * 64; i += NT) { const int row = i >> 6, c4 = i & 63; const float* pr = row < TP ? P.in[2] + (size_t)row * 256 : P.in[3] + (size_t)(row - TP) * 256;
          const f32x4 v = ((const f32x4*)pr)[c4]; u32x2 w; w.x = cvt_pk_bf16(v[0], v[1]); w.y = cvt_pk_bf16(v[2], v[3]); ((u32x2*)(PB + (size_t)row * 256))[c4] = w; } }
    { FRESH(); EpiSwiglu e{nullptr, SSQ2, H}; run_gemm(lds, XB, (const bf16_t*)(ws + W_GU2), T, 5632, 1024, e); }
    GSYNC();
    { FRESH(); EpiResid<true> e{nullptr, nullptr, XB, SSQ3, 0.5f, scr}; run_gemm(lds, H, (const bf16_t*)(ws + W_D2), T, 1024, FF, e); }
    { FRESH(); EpiEW<3> e{nullptr, nullptr, 0, (bf16_t*)(ws + R_PEO), 1024}; run_gemm(lds, (const bf16_t*)(ws + R_PB), (const bf16_t*)(ws + W_PE), T, 1024, 256, e); }
    GSYNC();
    if (DBG_STOP == 5) return;
    { FRESH(); EpiFinal e{SSQ3, (const bf16_t*)(ws + R_PEO), XB, P.out}; run_gemm(lds, XB, (const bf16_t*)(ws + W_PG), T, 1024, 1024, e); }
}

extern "C" void kernel_launch(void* const* d_in, const int* in_sizes, int n_in, void* d_out, int out_size, void* d_ws, size_t ws_size, hipStream_t stream) {
    static int grid = 0;
    if (grid == 0) {
        if (n_in != 28 || out_size != T * DM || ws_size < WS_NEED) { fprintf(stderr, "kernel_launch: unexpected shapes (n_in %d out %d ws %zu)\n", n_in, out_size, ws_size); grid = -1; return; }
        int dev = 0, cus = 0, per_cu = 0;
        hipGetDevice(&dev); hipDeviceGetAttribute(&cus, hipDeviceAttributeMultiprocessorCount, dev);
        hipFuncSetAttribute((const void*)mega_fwd, hipFuncAttributeMaxDynamicSharedMemorySize, LDS_BYTES);
        hipOccupancyMaxActiveBlocksPerMultiprocessor(&per_cu, (const void*)mega_fwd, 512, LDS_BYTES);
        if (per_cu < 1) per_cu = 1;
        grid = cus * 1;
        (void)hipGetLastError();
    }
    if (grid < 0) return;
    Params p{};
    for (int i = 0; i < 28; ++i) p.in[i] = (const float*)d_in[i];
    p.out = (float*)d_out; p.ws = (unsigned char*)d_ws;
    hipMemsetAsync((char*)d_ws + S_CTL, 0, CTL_BYTES, stream);
    void* args[] = {&p};
    hipError_t e = hipLaunchCooperativeKernel((const void*)mega_fwd, dim3(grid), dim3(512), args, LDS_BYTES, stream);
    if (e != hipSuccess) fprintf(stderr, "cooperative launch failed: %s (grid %d)\n", hipGetErrorString(e), grid);
}
```
